# Optimizing an MI355X kernel written in HIP

```python
import jax, jax.numpy as jnp
from jax import lax
import numpy as np

D_MODEL = 1024
BATCH = 4
SEQ = 4096
DEPTH = 2

CHUNK = 64
N_MIXERS = 2
N_CONV_LAYERS = (DEPTH + 1) // 2
N_GDN_LAYERS = DEPTH // 2
CONV_WIDTH = 3
GDN_HEADS = 8
GDN_HEAD_DIM = D_MODEL // GDN_HEADS
GDN_QK_DIM = GDN_HEADS * GDN_HEAD_DIM
GDN_V_DIM = GDN_HEADS * GDN_HEAD_DIM
GDN_CONV_WIDTH = 4
GDN_IN_DIM = 2 * GDN_QK_DIM + 2 * GDN_V_DIM + 2 * GDN_HEADS
N_GROUPS = 8
EXPERTS_PER_GROUP = 8
N_EXPERTS = N_GROUPS * EXPERTS_PER_GROUP
TOP_K = 2
D_EXPERT = D_MODEL // 4
D_SHARED = D_MODEL // 2
MOE_BLOCK = 128
NORM_EPS = 1e-6

kernel_name = "hybrid_conv_gdn_hier_moe_adaln"


def rmsnorm(x, w):
    xf = x.astype(jnp.float32)
    y = xf * lax.rsqrt(jnp.mean(xf * xf, axis=-1, keepdims=True) + NORM_EPS)
    return (y * w.astype(jnp.float32)).astype(x.dtype)


def l2norm(x):
    xf = x.astype(jnp.float32)
    return xf * lax.rsqrt(jnp.sum(xf * xf, axis=-1, keepdims=True) + NORM_EPS)


def causal_dwconv(x, w):
    K = w.shape[0]
    T = x.shape[1]
    xp = jnp.pad(x, ((0, 0), (K - 1, 0), (0, 0)))
    y = xp[:, 0:T] * w[0]
    for k in range(1, K):
        y = y + xp[:, k:k + T] * w[k]
    return y


def short_conv_mixer(h, w_in, conv_w, w_out):
    bcx = h @ w_in
    b, cg, xv = jnp.split(bcx, 3, axis=-1)
    y = b * causal_dwconv(cg * xv, conv_w)
    return y @ w_out


def chunk_gated_delta_rule(q, k, v, g, beta):
    out_dtype = v.dtype
    B, T, H, Dk = q.shape
    Dv = v.shape[-1]
    n = T // CHUNK

    def blocks(a):
        a = a.astype(jnp.float32).reshape((B, n, CHUNK, H) + a.shape[3:])
        return jnp.moveaxis(a, 3, 1)

    q, k, v, g, beta = (blocks(a) for a in (q, k, v, g, beta))
    gc = jnp.cumsum(g, axis=-1)
    idx = jnp.arange(CHUNK)
    causal = idx[:, None] >= idx[None, :]
    strict = idx[:, None] > idx[None, :]
    diff = gc[..., :, None] - gc[..., None, :]
    decay = jnp.exp(jnp.where(causal, diff, -jnp.inf))
    kb = k * beta[..., None]
    lower = jnp.where(strict, jnp.einsum('bhncd,bhnsd->bhncs', kb, k) * decay, 0.0)
    rhs = jnp.concatenate([v * beta[..., None], kb * jnp.exp(gc)[..., None]], axis=-1)
    sol = lax.linalg.triangular_solve(lower, rhs, left_side=True, lower=True,
                                      unit_diagonal=True)
    u, w = sol[..., :Dv], sol[..., Dv:]
    attn = jnp.einsum('bhncd,bhnsd->bhncs', q, k) * decay
    q_dec = q * jnp.exp(gc)[..., None]
    g_last = gc[..., -1]
    k_dec = k * jnp.exp(g_last[..., None] - gc)[..., None]

    def step(S, inp):
        u_n, w_n, qd_n, kd_n, a_n, gl_n = inp
        v_new = u_n - jnp.einsum('bhcd,bhde->bhce', w_n, S)
        o_n = (jnp.einsum('bhcd,bhde->bhce', qd_n, S)
               + jnp.einsum('bhcs,bhse->bhce', a_n, v_new))
        S = S * jnp.exp(gl_n)[..., None, None] + jnp.einsum('bhcd,bhce->bhde', kd_n, v_new)
        return S, o_n

    xs = tuple(jnp.moveaxis(a, 2, 0) for a in (u, w, q_dec, k_dec, attn, g_last))
    S0 = jnp.zeros((B, H, Dk, Dv), jnp.float32)
    _, o = lax.scan(step, S0, xs)
    o = jnp.transpose(o, (1, 0, 3, 2, 4)).reshape(B, T, H, Dv)
    return o.astype(out_dtype)


def gated_deltanet_mixer(h, w_in, conv_w, a_log, dt_bias, norm_w, w_out):
    B, T, _ = h.shape
    H, Dh = GDN_HEADS, GDN_HEAD_DIM
    proj = h @ w_in
    s1 = 2 * GDN_QK_DIM + GDN_V_DIM
    s2 = s1 + GDN_V_DIM
    qkv = proj[..., :s1]
    z = proj[..., s1:s2]
    b = proj[..., s2:s2 + H]
    a = proj[..., s2 + H:]
    qkv = jax.nn.silu(causal_dwconv(qkv, conv_w))
    q = qkv[..., :GDN_QK_DIM].reshape(B, T, H, Dh)
    k = qkv[..., GDN_QK_DIM:2 * GDN_QK_DIM].reshape(B, T, H, Dh)
    v = qkv[..., 2 * GDN_QK_DIM:].reshape(B, T, H, Dh)
    q = l2norm(q) * (Dh ** -0.5)
    k = l2norm(k)
    beta = jax.nn.sigmoid(b.astype(jnp.float32))
    g = -jnp.exp(a_log.astype(jnp.float32)) * jax.nn.softplus(
        a.astype(jnp.float32) + dt_bias.astype(jnp.float32))
    o = chunk_gated_delta_rule(q, k, v, g, beta)
    o = rmsnorm(o, norm_w) * jax.nn.silu(z.reshape(B, T, H, Dh))
    return o.reshape(B, T, GDN_V_DIM) @ w_out


def hier_moe(h, w_rg, b_rg, w_re, b_re, w_gate, w_up, w_down, ws_gate, ws_up, ws_down, w_sg):
    B, T, D = h.shape
    xt = h.reshape(-1, D)
    N = xt.shape[0]
    gl = (xt @ w_rg + b_rg).astype(jnp.float32)
    gp = jax.nn.softmax(gl, axis=-1)
    g_sel = jnp.argmax(gl, axis=-1)
    p_sel = jnp.take_along_axis(gp, g_sel[:, None], axis=-1)[:, 0]
    el = (xt @ w_re + b_re).astype(jnp.float32).reshape(N, N_GROUPS, EXPERTS_PER_GROUP)
    el_sel = jnp.take_along_axis(el, g_sel[:, None, None], axis=1)[:, 0]
    top_v, top_i = lax.top_k(el_sel, TOP_K)
    gate = jax.nn.softmax(top_v, axis=-1) * p_sel[:, None]
    eid = g_sel[:, None] * EXPERTS_PER_GROUP + top_i
    S = N * TOP_K
    flat_e = eid.reshape(-1)
    flat_tok = jnp.repeat(jnp.arange(N), TOP_K)
    flat_gate = gate.reshape(-1)
    order = jnp.argsort(flat_e)
    e_sorted = flat_e[order]
    tok_sorted = flat_tok[order]
    gate_sorted = flat_gate[order].astype(xt.dtype)
    counts = jnp.bincount(flat_e, length=N_EXPERTS)
    starts = jnp.cumsum(counts) - counts
    padded = (counts + MOE_BLOCK - 1) // MOE_BLOCK * MOE_BLOCK
    pends = jnp.cumsum(padded)
    pstarts = pends - padded
    dest = pstarts[e_sorted] + (jnp.arange(S) - starts[e_sorted])
    n_blocks = -(-S // MOE_BLOCK) + N_EXPERTS
    P = n_blocks * MOE_BLOCK
    buf = jnp.zeros((P, D), xt.dtype).at[dest].set(xt[tok_sorted])
    block_e = jnp.minimum(
        jnp.searchsorted(pends, jnp.arange(n_blocks) * MOE_BLOCK, side='right'), N_EXPERTS - 1)

    def expert_block(args):
        xb, e = args
        hid = jax.nn.silu(xb @ w_gate[e]) * (xb @ w_up[e])
        return hid @ w_down[e]

    out = lax.map(expert_block, (buf.reshape(n_blocks, MOE_BLOCK, D), block_e)).reshape(P, D)
    y = jnp.zeros((N, D), xt.dtype).at[tok_sorted].add(out[dest] * gate_sorted[:, None])
    ys = (jax.nn.silu(xt @ ws_gate) * (xt @ ws_up)) @ ws_down
    y = y + jax.nn.sigmoid(xt @ w_sg) * ys
    return y.reshape(B, T, D)


def setup_inputs(seed: int = 0) -> dict:
    key = jax.random.key(seed)
    ks = jax.random.split(key, 32)
    D = D_MODEL
    nrm = jax.random.normal
    f32 = jnp.float32
    dt = jnp.exp(jax.random.uniform(ks[11], (N_GDN_LAYERS, GDN_HEADS), f32,
                                    np.log(1e-3), np.log(1e-1)))
    return {
        "x": nrm(ks[0], (BATCH, SEQ, D), f32),
        "c": nrm(ks[1], (BATCH, D), f32),
        "ada_w": nrm(ks[2], (DEPTH, D, 6 * D), f32) * (0.3 * D ** -0.5),
        "ada_b": nrm(ks[3], (DEPTH, 6 * D), f32) * 0.02,
        "norm_w": 1.0 + 0.05 * nrm(ks[4], (DEPTH, 4, D), f32),
        "conv_in_w": nrm(ks[5], (N_CONV_LAYERS, D, 3 * D), f32) * D ** -0.5,
        "conv_w": nrm(ks[6], (N_CONV_LAYERS, CONV_WIDTH, D), f32) * CONV_WIDTH ** -0.5,
        "conv_out_w": nrm(ks[7], (N_CONV_LAYERS, D, D), f32) * D ** -0.5,
        "gdn_in_w": nrm(ks[8], (N_GDN_LAYERS, D, GDN_IN_DIM), f32) * D ** -0.5,
        "gdn_conv_w": nrm(ks[9], (N_GDN_LAYERS, GDN_CONV_WIDTH, 2 * GDN_QK_DIM + GDN_V_DIM), f32) * 0.5,
        "gdn_a_log": jnp.log(jax.random.uniform(ks[10], (N_GDN_LAYERS, GDN_HEADS), f32, 1.0, 16.0)),
        "gdn_dt_bias": dt + jnp.log(-jnp.expm1(-dt)),
        "gdn_norm_w": 1.0 + 0.05 * nrm(ks[12], (N_GDN_LAYERS, GDN_HEAD_DIM), f32),
        "gdn_out_w": nrm(ks[13], (N_GDN_LAYERS, GDN_V_DIM, D), f32) * GDN_V_DIM ** -0.5,
        "moe_group_w": nrm(ks[14], (DEPTH, D, N_GROUPS), f32) * D ** -0.5,
        "moe_group_b": nrm(ks[15], (DEPTH, N_GROUPS), f32) * 0.01,
        "moe_expert_w": nrm(ks[16], (DEPTH, D, N_EXPERTS), f32) * D ** -0.5,
        "moe_expert_b": nrm(ks[17], (DEPTH, N_EXPERTS), f32) * 0.01,
        "moe_w_gate": nrm(ks[18], (DEPTH, N_EXPERTS, D, D_EXPERT), f32) * D ** -0.5,
        "moe_w_up": nrm(ks[19], (DEPTH, N_EXPERTS, D, D_EXPERT), f32) * D ** -0.5,
        "moe_w_down": nrm(ks[20], (DEPTH, N_EXPERTS, D_EXPERT, D), f32) * D_EXPERT ** -0.5,
        "shared_w_gate": nrm(ks[21], (DEPTH, D, D_SHARED), f32) * D ** -0.5,
        "shared_w_up": nrm(ks[22], (DEPTH, D, D_SHARED), f32) * D ** -0.5,
        "shared_w_down": nrm(ks[23], (DEPTH, D_SHARED, D), f32) * D_SHARED ** -0.5,
        "shared_gate_w": nrm(ks[24], (DEPTH, D, 1), f32) * D ** -0.5,
    }


def reference(x, c, ada_w, ada_b, norm_w, conv_in_w, conv_w, conv_out_w,
              gdn_in_w, gdn_conv_w, gdn_a_log, gdn_dt_bias, gdn_norm_w, gdn_out_w,
              moe_group_w, moe_group_b, moe_expert_w, moe_expert_b,
              moe_w_gate, moe_w_up, moe_w_down,
              shared_w_gate, shared_w_up, shared_w_down, shared_gate_w):
    cs = jax.nn.silu(c)
    for i in range(DEPTH):
        mod = (cs @ ada_w[i] + ada_b[i])[:, None, :]
        sh1, sc1, gt1, sh2, sc2, gt2 = jnp.split(mod, 6, axis=-1)
        h = rmsnorm(x, norm_w[i, 0]) * (1.0 + sc1) + sh1
        j = i // N_MIXERS
        if i % N_MIXERS == 0:
            y = short_conv_mixer(h, conv_in_w[j], conv_w[j], conv_out_w[j])
        else:
            y = gated_deltanet_mixer(h, gdn_in_w[j], gdn_conv_w[j], gdn_a_log[j],
                                     gdn_dt_bias[j], gdn_norm_w[j], gdn_out_w[j])
        x = x + gt1 * rmsnorm(y, norm_w[i, 1])
        h = rmsnorm(x, norm_w[i, 2]) * (1.0 + sc2) + sh2
        y = hier_moe(h, moe_group_w[i], moe_group_b[i], moe_expert_w[i], moe_expert_b[i],
                     moe_w_gate[i], moe_w_up[i], moe_w_down[i],
                     shared_w_gate[i], shared_w_up[i], shared_w_down[i], shared_gate_w[i])
        x = x + gt2 * rmsnorm(y, norm_w[i, 3])
    return x
```

```cpp
#include <hip/hip_runtime.h>
#include <hip/hip_cooperative_groups.h>
#include <cstdio>
#include <cstdint>
namespace cg = cooperative_groups;

typedef unsigned short bf16_t;
typedef short bf16x8 __attribute__((ext_vector_type(8)));
typedef float f32x4 __attribute__((ext_vector_type(4)));
typedef unsigned u32x4 __attribute__((ext_vector_type(4)));
typedef unsigned u32x2 __attribute__((ext_vector_type(2)));

#ifndef N_LAUNCH_MODE
#define N_LAUNCH_MODE 0
#endif

constexpr int NT = 512;
constexpr int NTOK = 16384, DM = 1024, SEQ = 4096;
constexpr float EPS = 1e-6f;
constexpr int LDS_BYTES = 147456;
constexpr int NPHASE = 18;

constexpr size_t MiB = 1048576;
constexpr size_t WS_CTL    = 0;
constexpr size_t WS_MOD    = 65536;
constexpr size_t WS_GATES  = WS_MOD + 196608;
constexpr size_t WS_SG     = WS_GATES + 131072;
constexpr size_t WS_EGL    = WS_SG + 65536;
constexpr size_t WS_BA     = 1 * MiB;
constexpr size_t WS_LIST   = 2 * MiB;
constexpr size_t WS_W_CONVIN  = 6 * MiB;
constexpr size_t WS_W_CONVOUT = 12 * MiB;
constexpr size_t WS_W_GDNIN   = 14 * MiB;
constexpr size_t WS_W_GDNOUT  = 22 * MiB;
constexpr size_t WS_W_SHGU    = 24 * MiB;
constexpr size_t WS_W_SHD     = 28 * MiB;
constexpr size_t WS_W_MOEGU   = 30 * MiB;
constexpr size_t WS_W_MOED    = 94 * MiB;
constexpr size_t WS_HA        = 126 * MiB;
constexpr size_t WS_R         = 158 * MiB;
constexpr size_t R_PLANES = WS_R;
constexpr size_t R_O      = WS_R;
constexpr size_t R_WN     = WS_R + 128 * MiB;
constexpr size_t R_QD     = WS_R + 160 * MiB;
constexpr size_t R_KDT    = WS_R + 192 * MiB;
constexpr size_t R_UT     = WS_R + 224 * MiB;
constexpr size_t R_AT     = WS_R + 256 * MiB;
constexpr size_t R_YO     = WS_R + 128 * MiB;
constexpr size_t R_B      = WS_R;
constexpr size_t R_U      = WS_R + 32 * MiB;
constexpr size_t R_HIDR   = WS_R;
constexpr size_t R_HIDS   = WS_R + 32 * MiB;
constexpr size_t R_YBUF   = WS_R + 160 * MiB;
constexpr size_t WS_END   = WS_R + 272 * MiB;

struct Params {
    const float* x; const float* c; const float* ada_w; const float* ada_b; const float* norm_w;
    const float* conv_in_w; const float* conv_w; const float* conv_out_w;
    const float* gdn_in_w; const float* gdn_conv_w; const float* gdn_a_log; const float* gdn_dt_bias; const float* gdn_norm_w; const float* gdn_out_w;
    const float* moe_group_w; const float* moe_group_b; const float* moe_expert_w; const float* moe_expert_b;
    const float* moe_w_gate; const float* moe_w_up; const float* moe_w_down;
    const float* sh_w_gate; const float* sh_w_up; const float* sh_w_down; const float* sh_gate_w;
    float* out; unsigned char* ws; int ph_lo, ph_hi;
};

__device__ __forceinline__ int otid() { int t = threadIdx.x; asm volatile("" : "+v"(t)); return t; }
__device__ __forceinline__ int oblk() { int t = blockIdx.x; asm volatile("" : "+s"(t)); return t; }
__device__ __forceinline__ int ogrid() { int t = gridDim.x; asm volatile("" : "+s"(t)); return t; }
__device__ __forceinline__ unsigned f2bf(float f) { unsigned u = __float_as_uint(f); return (u + 0x7fffu + ((u >> 16) & 1u)) >> 16; }
__device__ __forceinline__ unsigned pk2(float lo, float hi) { return f2bf(lo) | (f2bf(hi) << 16); }
__device__ __forceinline__ float bflo(unsigned w) { return __uint_as_float(w << 16); }
__device__ __forceinline__ float bfhi(unsigned w) { return __uint_as_float(w & 0xffff0000u); }
__device__ __forceinline__ float wave_sum(float v) {
#pragma unroll
    for (int o = 32; o; o >>= 1) v += __shfl_xor(v, o);
    return v;
}
__device__ __forceinline__ float siluf(float x) { return x / (1.f + __expf(-x)); }
__device__ __forceinline__ float sigmf(float x) { return 1.f / (1.f + __expf(-x)); }

__device__ __forceinline__ void ld_row_f32(const float* row, int lane, float (&v)[16]) {
#pragma unroll
    for (int j = 0; j < 4; ++j) { const f32x4 t = *(const f32x4*)(row + 256 * j + 4 * lane); v[4 * j] = t[0]; v[4 * j + 1] = t[1]; v[4 * j + 2] = t[2]; v[4 * j + 3] = t[3]; }
}
__device__ __forceinline__ void ld_row_bf16(const bf16_t* row, int lane, float (&v)[16]) {
#pragma unroll
    for (int j = 0; j < 4; ++j) { const u32x2 t = *(const u32x2*)(row + 256 * j + 4 * lane); v[4 * j] = bflo(t[0]); v[4 * j + 1] = bfhi(t[0]); v[4 * j + 2] = bflo(t[1]); v[4 * j + 3] = bfhi(t[1]); }
}
__device__ __forceinline__ void st_row_f32(float* row, int lane, const float (&v)[16]) {
#pragma unroll
    for (int j = 0; j < 4; ++j) { f32x4 t; t[0] = v[4 * j]; t[1] = v[4 * j + 1]; t[2] = v[4 * j + 2]; t[3] = v[4 * j + 3]; *(f32x4*)(row + 256 * j + 4 * lane) = t; }
}
__device__ __forceinline__ void st_row_bf16(bf16_t* row, int lane, const float (&v)[16]) {
#pragma unroll
    for (int j = 0; j < 4; ++j) { u32x2 t; t[0] = pk2(v[4 * j], v[4 * j + 1]); t[1] = pk2(v[4 * j + 2], v[4 * j + 3]); *(u32x2*)(row + 256 * j + 4 * lane) = t; }
}
__device__ __forceinline__ float sumsq16(const float (&v)[16]) {
    float s = 0.f;
#pragma unroll
    for (int i = 0; i < 16; ++i) s += v[i] * v[i];
    return s;
}

struct TJob { const float* s0; const float* s1; bf16_t* dst; int K, Nd, ld, type, tpg, ngroups; long sstride, dstride; };
__device__ __forceinline__ const float* tjob_src(const TJob& j, const float* s0, const float* s1, int r) {
    if (j.type == 0) return s0 + r;
    if (j.type == 1) { if (r < 1024) return s0 + r; const int rr = r - 1024, blk = rr >> 5, hi = (rr >> 4) & 1; return s0 + 1024 + hi * 1024 + 16 * blk + (rr & 15); }
    const int blk = r >> 5, hi = (r >> 4) & 1; return (hi ? s1 : s0) + 16 * blk + (r & 15);
}
__device__ __forceinline__ void transpose_tile(float* tl, const TJob& j, int tile) {
    const int tid = otid();
    const int g = tile / j.tpg, tt = tile % j.tpg;
    const int nkt = j.K >> 6;
    const int r0 = (tt / nkt) * 64, k0 = (tt % nkt) * 64;
    const float* s0 = j.s0 + (long)g * j.sstride; const float* s1 = j.s1 ? j.s1 + (long)g * j.sstride : nullptr;
    bf16_t* dst = j.dst + (long)g * j.dstride;
    {
        const int rq = tid & 15, kk = tid >> 4;
        const float* sp = tjob_src(j, s0, s1, r0 + 4 * rq);
#pragma unroll
        for (int i = 0; i < 2; ++i) { const int k = kk + 32 * i; const f32x4 v = *(const f32x4*)(sp + (long)(k0 + k) * j.ld); *(f32x4*)(tl + k * 68 + 4 * rq) = v; }
    }
    __syncthreads();
    {
        const int r = tid >> 3, ks = (tid & 7) * 8;
        float v[8];
#pragma unroll
        for (int i = 0; i < 8; ++i) v[i] = tl[(ks + i) * 68 + r];
        u32x4 w; w[0] = pk2(v[0], v[1]); w[1] = pk2(v[2], v[3]); w[2] = pk2(v[4], v[5]); w[3] = pk2(v[6], v[7]);
        *(u32x4*)(dst + (long)(r0 + r) * j.K + k0 + ks) = w;
    }
    __syncthreads();
}
__device__ __forceinline__ void tjob_set(TJob* j, const float* s0, const float* s1, bf16_t* dst, int K, int Nd, int ld, int type, int ngroups, long sstride, long dstride) {
    j->s0 = s0; j->s1 = s1; j->dst = dst; j->K = K; j->Nd = Nd; j->ld = ld; j->type = type; j->tpg = (Nd >> 6) * (K >> 6); j->ngroups = ngroups; j->sstride = sstride; j->dstride = dstride;
}
__device__ __forceinline__ void run_tjobs(unsigned char* lds, int nj, int brel, int nb) {
    TJob* jobs = (TJob*)lds; float* tl = (float*)(lds + 4096);
    int base = 0;
    for (int q = 0; q < nj; ++q) {
        const TJob j = jobs[q];
        const int nt = j.tpg * j.ngroups;
        int first = (brel - base % nb + nb) % nb;
        for (int t = first; t < nt; t += nb) transpose_tile(tl, j, t);
        base += nt;
    }
}
__device__ __forceinline__ void moe_weight_jobs(const Params& p, int layer, TJob* jobs) {
    bf16_t* wgu = (bf16_t*)(p.ws + WS_W_MOEGU); bf16_t* wd = (bf16_t*)(p.ws + WS_W_MOED);
    const long lo = (long)layer * 64 * 1024 * 256;
    tjob_set(jobs + 0, p.moe_w_gate + lo, p.moe_w_up + lo, wgu, 1024, 512, 256, 2, 64, 1024L * 256, 512L * 1024);
    tjob_set(jobs + 1, p.moe_w_down + lo, nullptr, wd, 256, 1024, 1024, 0, 64, 256L * 1024, 1024L * 256);
}

__device__ __forceinline__ void phase_prologue(const Params& p, unsigned char* lds) {
    const int tid = otid();
    for (int u = oblk(); u < 192; u += ogrid()) {
        float* cs = (float*)lds; float* red = (float*)(lds + 16384);
        for (int i = tid; i < 4096; i += NT) cs[i] = siluf(p.c[i]);
        __syncthreads();
        const int l = u / 96, cgp = u % 96, col = tid & 63, kg = tid >> 6;
        const float* w = p.ada_w + (size_t)l * 1024 * 6144 + cgp * 64 + col;
        float a0 = 0.f, a1 = 0.f, a2 = 0.f, a3 = 0.f;
#pragma unroll 8
        for (int k = kg; k < 1024; k += 8) { const float wv = w[(size_t)k * 6144]; a0 += cs[k] * wv; a1 += cs[1024 + k] * wv; a2 += cs[2048 + k] * wv; a3 += cs[3072 + k] * wv; }
        red[(kg * 4 + 0) * 64 + col] = a0; red[(kg * 4 + 1) * 64 + col] = a1; red[(kg * 4 + 2) * 64 + col] = a2; red[(kg * 4 + 3) * 64 + col] = a3;
        __syncthreads();
        if (tid < 256) {
            const int b = tid >> 6; float s = 0.f;
#pragma unroll
            for (int g = 0; g < 8; ++g) s += red[(g * 4 + b) * 64 + col];
            float* mod = (float*)(p.ws + WS_MOD);
            mod[(l * 4 + b) * 6144 + cgp * 64 + col] = s + p.ada_b[l * 6144 + cgp * 64 + col];
        }
        __syncthreads();
    }
    TJob* jobs = (TJob*)lds;
    if (tid == 0) {
        unsigned char* ws = p.ws;
        tjob_set(jobs + 0, p.conv_in_w, nullptr, (bf16_t*)(ws + WS_W_CONVIN), 1024, 3072, 3072, 1, 1, 0, 0);
        tjob_set(jobs + 1, p.conv_out_w, nullptr, (bf16_t*)(ws + WS_W_CONVOUT), 1024, 1024, 1024, 0, 1, 0, 0);
        tjob_set(jobs + 2, p.gdn_in_w, nullptr, (bf16_t*)(ws + WS_W_GDNIN), 1024, 4096, 4112, 0, 1, 0, 0);
        tjob_set(jobs + 3, p.gdn_out_w, nullptr, (bf16_t*)(ws + WS_W_GDNOUT), 1024, 1024, 1024, 0, 1, 0, 0);
        tjob_set(jobs + 4, p.sh_w_gate, p.sh_w_up, (bf16_t*)(ws + WS_W_SHGU), 1024, 1024, 512, 2, 2, 1024L * 512, 1024L * 1024);
        tjob_set(jobs + 5, p.sh_w_down, nullptr, (bf16_t*)(ws + WS_W_SHD), 512, 1024, 1024, 0, 2, 512L * 1024, 1024L * 512);
        moe_weight_jobs(p, 0, jobs + 6);
    }
    __syncthreads();
    run_tjobs(lds, 8, oblk(), ogrid());
}

struct ColP { float v[16]; };
__device__ __forceinline__ void ld_colp(const float* base, int lane, ColP& c) { ld_row_f32(base, lane, c.v); }
__device__ __forceinline__ const float* modp(const Params& p, int l, int b, int chunk) { return (const float*)(p.ws + WS_MOD) + (l * 4 + b) * 6144 + chunk * 1024; }

__device__ __forceinline__ void phase_h0(const Params& p) {
    const int lane = otid() & 63, wid = otid() >> 6;
    bf16_t* hA = (bf16_t*)(p.ws + WS_HA);
    ColP nw; ld_colp(p.norm_w + 0, lane, nw);
    for (int tok = oblk() * 8 + wid; tok < NTOK; tok += ogrid() * 8) {
        const int b = tok >> 12;
        float v[16]; ld_row_f32(p.x + (size_t)tok * DM, lane, v);
        const float r = rsqrtf(wave_sum(sumsq16(v)) * (1.f / DM) + EPS);
        ColP sc, sh; ld_colp(modp(p, 0, b, 1), lane, sc); ld_colp(modp(p, 0, b, 0), lane, sh);
#pragma unroll
        for (int i = 0; i < 16; ++i) v[i] = v[i] * r * nw.v[i] * (1.f + sc.v[i]) + sh.v[i];
        st_row_bf16(hA + (size_t)tok * DM, lane, v);
    }
}

__device__ __forceinline__ void phase_conv(const Params& p) {
    const int lane = otid() & 63, wid = otid() >> 6;
    const bf16_t* Bb = (const bf16_t*)(p.ws + R_B); const bf16_t* Ub = (const bf16_t*)(p.ws + R_U);
    bf16_t* hA = (bf16_t*)(p.ws + WS_HA);
    ColP w0, w1, w2; ld_colp(p.conv_w, lane, w0); ld_colp(p.conv_w + 1024, lane, w1); ld_colp(p.conv_w + 2048, lane, w2);
    for (int tok = oblk() * 8 + wid; tok < NTOK; tok += ogrid() * 8) {
        const int t = tok & (SEQ - 1);
        float bb[16], u0[16], u1[16], u2[16];
        ld_row_bf16(Bb + (size_t)tok * DM, lane, bb);
        ld_row_bf16(Ub + (size_t)tok * DM, lane, u2);
        if (t >= 1) ld_row_bf16(Ub + (size_t)(tok - 1) * DM, lane, u1); else {
#pragma unroll
            for (int i = 0; i < 16; ++i) u1[i] = 0.f; }
        if (t >= 2) ld_row_bf16(Ub + (size_t)(tok - 2) * DM, lane, u0); else {
#pragma unroll
            for (int i = 0; i < 16; ++i) u0[i] = 0.f; }
        float y[16];
#pragma unroll
        for (int i = 0; i < 16; ++i) y[i] = bb[i] * (w0.v[i] * u0[i] + w1.v[i] * u1[i] + w2.v[i] * u2[i]);
        st_row_bf16(hA + (size_t)tok * DM, lane, y);
    }
}

template <int NCT, class BF>
__device__ __forceinline__ void smalln_gemm(const float* Hs, float* Ps, int wid, int lane, const BF& bf) {
    f32x4 acc[NCT];
#pragma unroll
    for (int c = 0; c < NCT; ++c) acc[c] = (f32x4){0.f, 0.f, 0.f, 0.f};
    const int row = lane & 15, kq = lane >> 4;
    const float* hrow = Hs + row * 1026 + 128 * wid + kq;
#pragma unroll 4
    for (int s = 0; s < 32; ++s) {
        const float a = hrow[4 * s];
        const int k = 128 * wid + 4 * s + kq;
#pragma unroll
        for (int c = 0; c < NCT; ++c) acc[c] = __builtin_amdgcn_mfma_f32_16x16x4f32(a, bf(k, c, row), acc[c], 0, 0, 0);
    }
#pragma unroll
    for (int c = 0; c < NCT; ++c)
#pragma unroll
        for (int r = 0; r < 4; ++r) Ps[(wid * 16 + 4 * kq + r) * (NCT * 16) + c * 16 + row] = acc[c][r];
}

struct RouteB {
    const float* we; const float* wg; const float* wsg;
    __device__ __forceinline__ float operator()(int k, int ct, int c16) const {
        if (ct < 4) return we[k * 64 + ct * 16 + c16];
        if (c16 < 8) return wg[k * 8 + c16];
        if (c16 == 8) return wsg[k];
        return 0.f;
    }
};
struct BaB { const float* w; __device__ __forceinline__ float operator()(int k, int, int c16) const { return w[(size_t)k * 4112 + 4096 + c16]; } };

__device__ __forceinline__ void phase_post_mixer(const Params& p, unsigned char* lds, int l) {
    const int tid = otid(), lane = tid & 63, wid = tid >> 6;
    float* Hs = (float*)lds;
    float* Ps = (float*)(lds + 65792);
    float* Lg = (float*)(lds + 65792 + 40960);
    const float* xin = (l == 0) ? p.x : p.out;
    const bf16_t* yo = (const bf16_t*)(p.ws + R_YO);
    bf16_t* hA = (bf16_t*)(p.ws + WS_HA);
    int* cnt = (int*)(p.ws + WS_CTL) + l * 64;
    int* list = (int*)(p.ws + WS_LIST);
    float* gates = (float*)(p.ws + WS_GATES); float* sgt = (float*)(p.ws + WS_SG);
    ColP nw1, nw2; ld_colp(p.norm_w + (l * 4 + 1) * 1024, lane, nw1); ld_colp(p.norm_w + (l * 4 + 2) * 1024, lane, nw2);
    RouteB rb; rb.we = p.moe_expert_w + (size_t)l * 1024 * 64; rb.wg = p.moe_group_w + (size_t)l * 1024 * 8; rb.wsg = p.sh_gate_w + (size_t)l * 1024;
    for (int g16 = oblk(); g16 < NTOK / 16; g16 += ogrid()) {
#pragma unroll 1
        for (int q = 0; q < 2; ++q) {
            const int tl = wid * 2 + q, tok = g16 * 16 + tl, b = tok >> 12;
            float xv[16], yv[16];
            ld_row_f32(xin + (size_t)tok * DM, lane, xv); ld_row_bf16(yo + (size_t)tok * DM, lane, yv);
            const float r1 = rsqrtf(wave_sum(sumsq16(yv)) * (1.f / DM) + EPS);
            ColP gt; ld_colp(modp(p, l, b, 2), lane, gt);
#pragma unroll
            for (int i = 0; i < 16; ++i) xv[i] = xv[i] + gt.v[i] * (yv[i] * r1 * nw1.v[i]);
            st_row_f32(p.out + (size_t)tok * DM, lane, xv);
            const float r2 = rsqrtf(wave_sum(sumsq16(xv)) * (1.f / DM) + EPS);
            ColP sc, sh; ld_colp(modp(p, l, b, 4), lane, sc); ld_colp(modp(p, l, b, 3), lane, sh);
#pragma unroll
            for (int i = 0; i < 16; ++i) xv[i] = xv[i] * r2 * nw2.v[i] * (1.f + sc.v[i]) + sh.v[i];
            st_row_bf16(hA + (size_t)tok * DM, lane, xv);
#pragma unroll
            for (int j = 0; j < 4; ++j)
#pragma unroll
                for (int i = 0; i < 4; ++i) Hs[tl * 1026 + 256 * j + 4 * lane + i] = xv[4 * j + i];
        }
        __syncthreads();
        smalln_gemm<5>(Hs, Ps, wid, lane, rb);
        __syncthreads();
        for (int i = tid; i < 16 * 80; i += NT) { float s = 0.f;
#pragma unroll
            for (int w = 0; w < 8; ++w) s += Ps[w * 1280 + i];
            Lg[i] = s; }
        __syncthreads();
        if (tid < 16) {
            const int tok = g16 * 16 + tid; const float* lg = Lg + tid * 80;
            float gl[8]; float gm = -3.4e38f; int gs = 0;
#pragma unroll
            for (int g = 0; g < 8; ++g) { gl[g] = lg[64 + g] + p.moe_group_b[l * 8 + g]; if (gl[g] > gm) { gm = gl[g]; gs = g; } }
            float den = 0.f;
#pragma unroll
            for (int g = 0; g < 8; ++g) den += __expf(gl[g] - gm);
            const float psel = 1.f / den;
            float el[8];
#pragma unroll
            for (int j = 0; j < 8; ++j) el[j] = lg[gs * 8 + j] + p.moe_expert_b[l * 64 + gs * 8 + j];
            float v1 = -3.4e38f; int i1 = 0;
#pragma unroll
            for (int j = 0; j < 8; ++j) if (el[j] > v1) { v1 = el[j]; i1 = j; }
            float v2 = -3.4e38f; int i2 = 0;
#pragma unroll
            for (int j = 0; j < 8; ++j) if (j != i1 && el[j] > v2) { v2 = el[j]; i2 = j; }
            const float e2 = __expf(v2 - v1);
            const float g1 = psel / (1.f + e2), g2 = psel * e2 / (1.f + e2);
            const int e1id = gs * 8 + i1, e2id = gs * 8 + i2;
            gates[tok * 2] = g1; gates[tok * 2 + 1] = g2; sgt[tok] = sigmf(lg[72]);
            const int p1 = atomicAdd(&cnt[e1id], 1); list[e1id * NTOK + p1] = tok * 2;
            const int p2 = atomicAdd(&cnt[e2id], 1); list[e2id * NTOK + p2] = tok * 2 + 1;
        }
        __syncthreads();
    }
}

__device__ __forceinline__ void phase_post_moe(const Params& p, unsigned char* lds, int l, bool final) {
    const int tid = otid(), lane = tid & 63, wid = tid >> 6;
    float* Hs = (float*)lds; float* Ps = (float*)(lds + 65792);
    const bf16_t* yb = (const bf16_t*)(p.ws + R_YBUF);
    bf16_t* hA = (bf16_t*)(p.ws + WS_HA);
    float* ba = (float*)(p.ws + WS_BA);
    ColP nw3, nwn; ld_colp(p.norm_w + (l * 4 + 3) * 1024, lane, nw3);
    if (!final) ld_colp(p.norm_w + ((l + 1) * 4 + 0) * 1024, lane, nwn);
    BaB bb; bb.w = p.gdn_in_w;
    for (int g16 = oblk(); g16 < NTOK / 16; g16 += ogrid()) {
#pragma unroll 1
        for (int q = 0; q < 2; ++q) {
            const int tl = wid * 2 + q, tok = g16 * 16 + tl, b = tok >> 12;
            float xv[16], yv[16], t1[16];
            ld_row_f32(p.out + (size_t)tok * DM, lane, xv);
            ld_row_bf16(yb + (size_t)tok * DM, lane, yv);
            ld_row_bf16(yb + (size_t)(NTOK + tok) * DM, lane, t1);
#pragma unroll
            for (int i = 0; i < 16; ++i) yv[i] += t1[i];
            ld_row_bf16(yb + (size_t)(2 * NTOK + tok) * DM, lane, t1);
#pragma unroll
            for (int i = 0; i < 16; ++i) yv[i] += t1[i];
            const float r1 = rsqrtf(wave_sum(sumsq16(yv)) * (1.f / DM) + EPS);
            ColP gt; ld_colp(modp(p, l, b, 5), lane, gt);
#pragma unroll
            for (int i = 0; i < 16; ++i) xv[i] = xv[i] + gt.v[i] * (yv[i] * r1 * nw3.v[i]);
            st_row_f32(p.out + (size_t)tok * DM, lane, xv);
            if (!final) {
                const float r2 = rsqrtf(wave_sum(sumsq16(xv)) * (1.f / DM) + EPS);
                ColP sc, sh; ld_colp(modp(p, l + 1, b, 1), lane, sc); ld_colp(modp(p, l + 1, b, 0), lane, sh);
#pragma unroll
                for (int i = 0; i < 16; ++i) xv[i] = xv[i] * r2 * nwn.v[i] * (1.f + sc.v[i]) + sh.v[i];
                st_row_bf16(hA + (size_t)tok * DM, lane, xv);
#pragma unroll
                for (int j = 0; j < 4; ++j)
#pragma unroll
                    for (int i = 0; i < 4; ++i) Hs[tl * 1026 + 256 * j + 4 * lane + i] = xv[4 * j + i];
            }
        }
        if (!final) {
            __syncthreads();
            smalln_gemm<1>(Hs, Ps, wid, lane, bb);
            __syncthreads();
            if (tid < 256) { float s = 0.f;
#pragma unroll
                for (int w = 0; w < 8; ++w) s += Ps[w * 256 + tid];
                ba[(size_t)(g16 * 16) * 16 + tid] = s; }
            __syncthreads();
        }
    }
}

__device__ __forceinline__ void phase_gdn_gate(const Params& p) {
    const int lane = otid() & 63, wid = otid() >> 6;
    const float* o = (const float*)(p.ws + R_O);
    const bf16_t* z = (const bf16_t*)(p.ws + R_PLANES) + (size_t)3 * NTOK * DM;
    bf16_t* hA = (bf16_t*)(p.ws + WS_HA);
    float gw[16];
#pragma unroll
    for (int j = 0; j < 4; ++j)
#pragma unroll
        for (int i = 0; i < 4; ++i) gw[4 * j + i] = p.gdn_norm_w[(4 * lane + i) & 127];
    for (int tok = oblk() * 8 + wid; tok < NTOK; tok += ogrid() * 8) {
        float ov[16], zv[16];
        ld_row_f32(o + (size_t)tok * DM, lane, ov); ld_row_bf16(z + (size_t)tok * DM, lane, zv);
#pragma unroll
        for (int j = 0; j < 4; ++j) {
            float s = ov[4 * j] * ov[4 * j] + ov[4 * j + 1] * ov[4 * j + 1] + ov[4 * j + 2] * ov[4 * j + 2] + ov[4 * j + 3] * ov[4 * j + 3];
#pragma unroll
            for (int of = 16; of; of >>= 1) s += __shfl_xor(s, of);
            const float r = rsqrtf(s * (1.f / 128.f) + EPS);
#pragma unroll
            for (int i = 0; i < 4; ++i) ov[4 * j + i] = ov[4 * j + i] * r * gw[4 * j + i] * siluf(zv[4 * j + i]);
        }
        st_row_bf16(hA + (size_t)tok * DM, lane, ov);
    }
}

template <class Epi>
__device__ __forceinline__ void gemm_unit(unsigned char* lds, const bf16_t* A, const int* gidx, int gvalid, const bf16_t* Bt, int K, const Epi& E) {
    const int tid = otid(), wid = tid >> 6, lane = tid & 63, wr = wid >> 2, wc = wid & 3, fr = lane & 15, fq = lane >> 4;
    unsigned char* As = lds; unsigned char* Bs = lds + 256 * 80;
    const bf16_t* ap[2]; const bf16_t* bp[2]; int lo[2];
#pragma unroll
    for (int i = 0; i < 2; ++i) {
        const int pc = tid + 512 * i, row = pc >> 2, seg = pc & 3;
        long arow = row;
        if (gidx) arow = (long)(gidx[row < gvalid ? row : 0] >> 1);
        ap[i] = A + arow * K + seg * 8; bp[i] = Bt + (long)row * K + seg * 8; lo[i] = row * 80 + seg * 16;
    }
    f32x4 acc[2][2][4][2];
#pragma unroll
    for (int a = 0; a < 2; ++a)
#pragma unroll
        for (int b = 0; b < 2; ++b)
#pragma unroll
            for (int m = 0; m < 4; ++m)
#pragma unroll
                for (int n = 0; n < 2; ++n) acc[a][b][m][n] = (f32x4){0.f, 0.f, 0.f, 0.f};
    u32x4 ra[2], rb[2];
#pragma unroll
    for (int i = 0; i < 2; ++i) { ra[i] = *(const u32x4*)ap[i]; rb[i] = *(const u32x4*)bp[i]; }
    const int nk = K >> 5;
    for (int kt = 0; kt < nk; ++kt) {
        __syncthreads();
#pragma unroll
        for (int i = 0; i < 2; ++i) { *(u32x4*)(As + lo[i]) = ra[i]; *(u32x4*)(Bs + lo[i]) = rb[i]; }
        __syncthreads();
        if (kt + 1 < nk) {
#pragma unroll
            for (int i = 0; i < 2; ++i) { ra[i] = *(const u32x4*)(ap[i] + (kt + 1) * 32); rb[i] = *(const u32x4*)(bp[i] + (kt + 1) * 32); }
        }
        bf16x8 Af[2][4], Bf[2][2];
#pragma unroll
        for (int a = 0; a < 2; ++a)
#pragma unroll
            for (int m = 0; m < 4; ++m) Af[a][m] = *(const bf16x8*)(As + (128 * a + 64 * wr + 16 * m + fr) * 80 + fq * 16);
#pragma unroll
        for (int b = 0; b < 2; ++b)
#pragma unroll
            for (int n = 0; n < 2; ++n) Bf[b][n] = *(const bf16x8*)(Bs + (128 * b + 32 * wc + 16 * n + fr) * 80 + fq * 16);
#pragma unroll
        for (int a = 0; a < 2; ++a)
#pragma unroll
            for (int b = 0; b < 2; ++b)
#pragma unroll
                for (int m = 0; m < 4; ++m)
#pragma unroll
                    for (int n = 0; n < 2; ++n) acc[a][b][m][n] = __builtin_amdgcn_mfma_f32_16x16x32_bf16(Bf[b][n], Af[a][m], acc[a][b][m][n], 0, 0, 0);
    }
#pragma unroll
    for (int a = 0; a < 2; ++a)
#pragma unroll
        for (int b = 0; b < 2; ++b)
#pragma unroll
            for (int m = 0; m < 4; ++m) E(128 * a + 64 * wr + 16 * m + fr, 128 * b + 32 * wc + 4 * fq, acc[a][b][m][0], acc[a][b][m][1]);
    __syncthreads();
}

__device__ __forceinline__ void st4bf(bf16_t* p, const f32x4& v) { u32x2 t; t[0] = pk2(v[0], v[1]); t[1] = pk2(v[2], v[3]); *(u32x2*)p = t; }

struct EpiPlain { bf16_t* O; int ldc; int row0, col0;
    __device__ __forceinline__ void operator()(int r, int c, const f32x4& v0, const f32x4& v1) const {
        bf16_t* q = O + (size_t)(row0 + r) * ldc + col0 + c; st4bf(q, v0); st4bf(q + 16, v1); } };
struct EpiConvIn { bf16_t* Bb; bf16_t* Ub; int row0, pn;
    __device__ __forceinline__ void operator()(int r, int c, const f32x4& v0, const f32x4& v1) const {
        if (pn < 4) { bf16_t* q = Bb + (size_t)(row0 + r) * DM + pn * 256 + c; st4bf(q, v0); st4bf(q + 16, v1); }
        else { const int uc = (pn - 4) * 128 + (c >> 5) * 16 + (c & 15); f32x4 u = v0 * v1; st4bf(Ub + (size_t)(row0 + r) * DM + uc, u); } } };
struct EpiGU { bf16_t* H; int ldh; int row0, pn;
    __device__ __forceinline__ void operator()(int r, int c, const f32x4& v0, const f32x4& v1) const {
        f32x4 h; h[0] = siluf(v0[0]) * v1[0]; h[1] = siluf(v0[1]) * v1[1]; h[2] = siluf(v0[2]) * v1[2]; h[3] = siluf(v0[3]) * v1[3];
        st4bf(H + (size_t)(row0 + r) * ldh + pn * 128 + (c >> 5) * 16 + (c & 15), h); } };
struct EpiDownR { bf16_t* Y; const int* lst; const float* gates; int valid, pn;
    __device__ __forceinline__ void operator()(int r, int c, const f32x4& v0, const f32x4& v1) const {
        if (r < valid) { const int e = lst[r]; const float g = gates[e]; bf16_t* q = Y + ((size_t)(e & 1) * NTOK + (e >> 1)) * DM + pn * 256 + c; st4bf(q, v0 * g); st4bf(q + 16, v1 * g); } } };
struct EpiDownS { bf16_t* Y; const float* sg; int row0, pn;
    __device__ __forceinline__ void operator()(int r, int c, const f32x4& v0, const f32x4& v1) const {
        const float g = sg[row0 + r]; bf16_t* q = Y + (size_t)(row0 + r) * DM + pn * 256 + c; st4bf(q, v0 * g); st4bf(q + 16, v1 * g); } };

__device__ __forceinline__ void phase_gemm_convin(const Params& p, unsigned char* lds) {
    const bf16_t* A = (const bf16_t*)(p.ws + WS_HA); const bf16_t* Bt = (const bf16_t*)(p.ws + WS_W_CONVIN);
    for (int u = oblk(); u < 64 * 12; u += ogrid()) {
        const int pm = u / 12, pn = u % 12;
        EpiConvIn E; E.Bb = (bf16_t*)(p.ws + R_B); E.Ub = (bf16_t*)(p.ws + R_U); E.row0 = pm * 256; E.pn = pn;
        gemm_unit(lds, A + (size_t)pm * 256 * 1024, nullptr, 0, Bt + (size_t)pn * 256 * 1024, 1024, E);
    }
}
__device__ __forceinline__ void phase_gemm_plain(const Params& p, unsigned char* lds, const bf16_t* A, const bf16_t* Bt, int nN, int K, bf16_t* O, int ldc, int planes) {
    for (int u = oblk(); u < 64 * nN; u += ogrid()) {
        const int pm = u / nN, pn = u % nN;
        EpiPlain E; E.ldc = ldc; E.row0 = pm * 256;
        if (planes) { E.O = O + (size_t)(pn >> 2) * NTOK * DM; E.col0 = (pn & 3) * 256; } else { E.O = O; E.col0 = pn * 256; }
        gemm_unit(lds, A + (size_t)pm * 256 * K, nullptr, 0, Bt + (size_t)pn * 256 * K, K, E);
    }
}

__device__ __forceinline__ void moe_tiles(const Params& p, int l, int* ts) {
    if (otid() == 0) { const int* cnt = (const int*)(p.ws + WS_CTL) + l * 64; int s = 0; for (int e = 0; e < 64; ++e) { ts[e] = s; s += (cnt[e] + 255) >> 8; } ts[64] = s; }
    __syncthreads();
}
__device__ __forceinline__ void phase_moe_gu(const Params& p, unsigned char* lds, int l) {
    int* ts = (int*)(lds + 131072);
    moe_tiles(p, l, ts);
    const int* cnt = (const int*)(p.ws + WS_CTL) + l * 64; const int* list = (const int*)(p.ws + WS_LIST);
    const bf16_t* hA = (const bf16_t*)(p.ws + WS_HA);
    const int nr = ts[64] * 2, ns = 64 * 4;
    for (int u = oblk(); u < nr + ns; u += ogrid()) {
        if (u < nr) {
            const int mt = u >> 1, pn = u & 1; int e = 0;
            for (int q = 1; q < 64; ++q) if (ts[q] <= mt) e = q;
            const int base = (mt - ts[e]) * 256; const int valid = min(256, cnt[e] - base);
            EpiGU E; E.H = (bf16_t*)(p.ws + R_HIDR); E.ldh = 256; E.row0 = mt * 256; E.pn = pn;
            gemm_unit(lds, hA, list + (size_t)e * NTOK + base, valid, (const bf16_t*)(p.ws + WS_W_MOEGU) + ((size_t)e * 512 + pn * 256) * 1024, 1024, E);
        } else {
            const int v = u - nr, pm = v >> 2, pn = v & 3;
            EpiGU E; E.H = (bf16_t*)(p.ws + R_HIDS); E.ldh = 512; E.row0 = pm * 256; E.pn = pn;
            gemm_unit(lds, hA + (size_t)pm * 256 * 1024, nullptr, 0, (const bf16_t*)(p.ws + WS_W_SHGU) + ((size_t)l * 1024 + pn * 256) * 1024, 1024, E);
        }
    }
}
__device__ __forceinline__ void phase_moe_down(const Params& p, unsigned char* lds, int l) {
    int* ts = (int*)(lds + 131072);
    moe_tiles(p, l, ts);
    const int* cnt = (const int*)(p.ws + WS_CTL) + l * 64; const int* list = (const int*)(p.ws + WS_LIST);
    const int nr = ts[64] * 4, ns = 64 * 4;
    bf16_t* yb = (bf16_t*)(p.ws + R_YBUF);
    for (int u = oblk(); u < nr + ns; u += ogrid()) {
        if (u < nr) {
            const int mt = u >> 2, pn = u & 3; int e = 0;
            for (int q = 1; q < 64; ++q) if (ts[q] <= mt) e = q;
            const int base = (mt - ts[e]) * 256; const int valid = min(256, cnt[e] - base);
            EpiDownR E; E.Y = yb; E.lst = list + (size_t)e * NTOK + base; E.gates = (const float*)(p.ws + WS_GATES); E.valid = valid; E.pn = pn;
            gemm_unit(lds, (const bf16_t*)(p.ws + R_HIDR) + (size_t)mt * 256 * 256, nullptr, 0, (const bf16_t*)(p.ws + WS_W_MOED) + ((size_t)e * 1024 + pn * 256) * 256, 256, E);
        } else {
            const int v = u - nr, pm = v >> 2, pn = v & 3;
            EpiDownS E; E.Y = yb + (size_t)2 * NTOK * DM; E.sg = (const float*)(p.ws + WS_SG); E.row0 = pm * 256; E.pn = pn;
            gemm_unit(lds, (const bf16_t*)(p.ws + R_HIDS) + (size_t)pm * 256 * 512, nullptr, 0, (const bf16_t*)(p.ws + WS_W_SHD) + ((size_t)l * 1024 + pn * 256) * 512, 512, E);
        }
    }
}

__device__ __forceinline__ void phase_gdn_prep(const Params& p, unsigned char* lds) {
    unsigned char* Qs = lds;
    unsigned char* Ks = lds + 17408;
    float* RHS = (float*)(lds + 34816);
    float* Lm = (float*)(lds + 34816 + 65536);
    float* betas = (float*)(lds + 34816 + 65536 + 16384);
    float* gcs = betas + 64;
    const bf16_t* planes = (const bf16_t*)(p.ws + R_PLANES);
    const float* ba = (const float*)(p.ws + WS_BA);
    bf16_t* Wn = (bf16_t*)(p.ws + R_WN); bf16_t* Qd = (bf16_t*)(p.ws + R_QD); bf16_t* KdT = (bf16_t*)(p.ws + R_KDT); bf16_t* UT = (bf16_t*)(p.ws + R_UT); bf16_t* At = (bf16_t*)(p.ws + R_AT);
    float* egl = (float*)(p.ws + WS_EGL);
    for (int cu = oblk(); cu < 2048; cu += ogrid()) {
        const int tid = otid(), lane = tid & 63, wid = tid >> 6;
        const int n = cu & 63, h = (cu >> 6) & 7, b = cu >> 9;
        const int tok0 = b * SEQ + n * 64;
        if (wid == 0) {
            const float bb = ba[(size_t)(tok0 + lane) * 16 + h], aa = ba[(size_t)(tok0 + lane) * 16 + 8 + h];
            const float beta = sigmf(bb);
            const float xs = aa + p.gdn_dt_bias[h];
            const float sp = fmaxf(xs, 0.f) + log1pf(__expf(-fabsf(xs)));
            float g = -__expf(p.gdn_a_log[h]) * sp;
#pragma unroll
            for (int o = 1; o < 64; o <<= 1) { const float t = __shfl_up(g, o); if (lane >= o) g += t; }
            betas[lane] = beta; gcs[lane] = g;
            if (lane == 63) egl[cu] = __expf(g);
        }
        __syncthreads();
        const float glast = gcs[63];
        {
            const int r = tid >> 3, cs = (tid & 7) * 16;
            const float beta = betas[r], gc = gcs[r];
#pragma unroll 1
            for (int pl = 0; pl < 3; ++pl) {
                float a[16];
#pragma unroll
                for (int i = 0; i < 16; ++i) a[i] = 0.f;
                const int ch = pl * 1024 + h * 128 + cs;
#pragma unroll
                for (int j = 0; j < 4; ++j) {
                    const int tt = n * 64 + r - 3 + j;
                    if (tt >= 0) {
                        const bf16_t* src = planes + ((size_t)pl * NTOK + (size_t)(b * SEQ + tt)) * DM + h * 128 + cs;
                        const u32x4 w0 = *(const u32x4*)src, w1 = *(const u32x4*)(src + 8);
                        const float* cw = p.gdn_conv_w + j * 3072 + ch;
                        const f32x4 c0 = *(const f32x4*)cw, c1 = *(const f32x4*)(cw + 4), c2 = *(const f32x4*)(cw + 8), c3 = *(const f32x4*)(cw + 12);
                        a[0] += c0[0] * bflo(w0[0]); a[1] += c0[1] * bfhi(w0[0]); a[2] += c0[2] * bflo(w0[1]); a[3] += c0[3] * bfhi(w0[1]);
                        a[4] += c1[0] * bflo(w0[2]); a[5] += c1[1] * bfhi(w0[2]); a[6] += c1[2] * bflo(w0[3]); a[7] += c1[3] * bfhi(w0[3]);
                        a[8] += c2[0] * bflo(w1[0]); a[9] += c2[1] * bfhi(w1[0]); a[10] += c2[2] * bflo(w1[1]); a[11] += c2[3] * bfhi(w1[1]);
                        a[12] += c3[0] * bflo(w1[2]); a[13] += c3[1] * bfhi(w1[2]); a[14] += c3[2] * bflo(w1[3]); a[15] += c3[3] * bfhi(w1[3]);
                    }
                }
                float ss = 0.f;
#pragma unroll
                for (int i = 0; i < 16; ++i) { a[i] = siluf(a[i]); ss += a[i] * a[i]; }
#pragma unroll
                for (int o = 1; o < 8; o <<= 1) ss += __shfl_xor(ss, o);
                if (pl == 0) {
                    const float rq = rsqrtf(ss + EPS) * 0.08838834764831845f, eg = __expf(gc);
                    unsigned qw[8], qdw[8];
#pragma unroll
                    for (int i = 0; i < 8; ++i) { const float q0 = a[2 * i] * rq, q1 = a[2 * i + 1] * rq; qw[i] = pk2(q0, q1); qdw[i] = pk2(q0 * eg, q1 * eg); }
                    *(u32x4*)(Qs + r * 272 + cs * 2) = (u32x4){qw[0], qw[1], qw[2], qw[3]}; *(u32x4*)(Qs + r * 272 + cs * 2 + 16) = (u32x4){qw[4], qw[5], qw[6], qw[7]};
                    bf16_t* qd = Qd + ((size_t)cu * 64 + r) * 128 + cs;
                    *(u32x4*)qd = (u32x4){qdw[0], qdw[1], qdw[2], qdw[3]}; *(u32x4*)(qd + 8) = (u32x4){qdw[4], qdw[5], qdw[6], qdw[7]};
                } else if (pl == 1) {
                    const float rk = rsqrtf(ss + EPS), ekd = __expf(glast - gc), kb = beta * __expf(gc);
                    unsigned kw[8];
#pragma unroll
                    for (int i = 0; i < 8; ++i) {
                        const float k0 = a[2 * i] * rk, k1 = a[2 * i + 1] * rk; kw[i] = pk2(k0, k1);
                        RHS[r * 256 + 128 + cs + 2 * i] = k0 * kb; RHS[r * 256 + 128 + cs + 2 * i + 1] = k1 * kb;
                        KdT[((size_t)cu * 128 + cs + 2 * i) * 64 + r] = (bf16_t)f2bf(k0 * ekd);
                        KdT[((size_t)cu * 128 + cs + 2 * i + 1) * 64 + r] = (bf16_t)f2bf(k1 * ekd);
                    }
                    *(u32x4*)(Ks + r * 272 + cs * 2) = (u32x4){kw[0], kw[1], kw[2], kw[3]}; *(u32x4*)(Ks + r * 272 + cs * 2 + 16) = (u32x4){kw[4], kw[5], kw[6], kw[7]};
                } else {
#pragma unroll
                    for (int i = 0; i < 16; ++i) RHS[r * 256 + cs + i] = a[i] * beta;
                }
            }
        }
        __syncthreads();
        {
            const int ti = wid & 3, isq = wid >> 2, fr = lane & 15, fq = lane >> 4;
            const unsigned char* Xs = isq ? Qs : Ks;
            bf16x8 af[4];
#pragma unroll
            for (int ks = 0; ks < 4; ++ks) af[ks] = *(const bf16x8*)(Xs + (16 * ti + fr) * 272 + (32 * ks + 8 * fq) * 2);
#pragma unroll
            for (int tj = 0; tj < 4; ++tj) {
                if (tj <= ti) {
                    f32x4 acc = (f32x4){0.f, 0.f, 0.f, 0.f};
#pragma unroll
                    for (int ks = 0; ks < 4; ++ks) { const bf16x8 bfg = *(const bf16x8*)(Ks + (16 * tj + fr) * 272 + (32 * ks + 8 * fq) * 2); acc = __builtin_amdgcn_mfma_f32_16x16x32_bf16(af[ks], bfg, acc, 0, 0, 0); }
                    const int jj = 16 * tj + fr; const float gj = gcs[jj];
#pragma unroll
                    for (int rg = 0; rg < 4; ++rg) {
                        const int ii = 16 * ti + 4 * fq + rg; const float gi = gcs[ii];
                        if (isq) { const float v = (ii >= jj) ? acc[rg] * __expf(gi - gj) : 0.f; At[((size_t)cu * 64 + ii) * 64 + jj] = (bf16_t)f2bf(v); }
                        else { Lm[jj * 64 + ii] = (ii > jj) ? acc[rg] * betas[ii] * __expf(gi - gj) : 0.f; }
                    }
                } else if (isq) {
#pragma unroll
                    for (int rg = 0; rg < 4; ++rg) At[((size_t)cu * 64 + 16 * ti + 4 * fq + rg) * 64 + 16 * tj + fr] = 0;
                }
            }
        }
        __syncthreads();
        if (tid < 256) {
            const int tid = otid();
            float rr[64];
#pragma unroll
            for (int i = 0; i < 64; ++i) rr[i] = RHS[i * 256 + tid];
            const bool isu = tid < 128;
            bf16_t* op = isu ? UT + ((size_t)cu * 128 + tid) * 64 : Wn + (size_t)cu * 64 * 128 + (tid - 128);
            const int ostr = isu ? 1 : 128;
            const unsigned sgn = isu ? 0u : 0x80000000u;
#pragma unroll
            for (int j = 0; j < 64; ++j) {
                const float xj = rr[j];
#pragma unroll
                for (int i4 = (j + 1) / 4; i4 < 16; ++i4) {
                    const f32x4 lv = *(const f32x4*)(Lm + j * 64 + 4 * i4);
#pragma unroll
                    for (int q = 0; q < 4; ++q) if (4 * i4 + q > j) rr[4 * i4 + q] -= lv[q] * xj;
                }
                op[j * ostr] = (bf16_t)f2bf(__uint_as_float(__float_as_uint(xj) ^ sgn));
                asm volatile("" ::: "memory");
            }
        }
        __syncthreads();
    }
}

__device__ __forceinline__ void phase_gdn_scan(const Params& p, unsigned char* lds) {
    const int tid = otid(), lane = tid & 63, wid = tid >> 6, fr = lane & 15, fq = lane >> 4;
    if (oblk() >= 64) {
        if (ogrid() > 64) {
            TJob* jobs = (TJob*)lds;
            if (tid == 0) moe_weight_jobs(p, 1, jobs);
            __syncthreads();
            run_tjobs(lds, 2, oblk() - 64, ogrid() - 64);
        }
        return;
    }
    unsigned char* St = lds;
    unsigned char* Vt = lds + 17408;
    const bf16_t* Wn = (const bf16_t*)(p.ws + R_WN); const bf16_t* Qd = (const bf16_t*)(p.ws + R_QD); const bf16_t* KdT = (const bf16_t*)(p.ws + R_KDT);
    const bf16_t* UT = (const bf16_t*)(p.ws + R_UT); const bf16_t* At = (const bf16_t*)(p.ws + R_AT);
    const float* egl = (const float*)(p.ws + WS_EGL);
    float* O = (float*)(p.ws + R_O);
    const int cm = wid >> 1, nq = wid & 1;
    for (int unit = oblk(); unit < 64; unit += ogrid()) {
        const int nh = unit & 1, bh = unit >> 1, h = bh & 7, b = bh >> 3;
        for (int i = tid; i < 17408 / 4; i += NT) ((unsigned*)St)[i] = 0u;
        f32x4 sacc[2][2];
#pragma unroll
        for (int a = 0; a < 2; ++a)
#pragma unroll
            for (int c = 0; c < 2; ++c) sacc[a][c] = (f32x4){0.f, 0.f, 0.f, 0.f};
        __syncthreads();
        for (int n = 0; n < 64; ++n) {
            const size_t cu = (size_t)bh * 64 + n;
            bf16x8 sf[2][4];
#pragma unroll
            for (int j = 0; j < 2; ++j)
#pragma unroll
                for (int ks = 0; ks < 4; ++ks) sf[j][ks] = *(const bf16x8*)(St + (16 * (2 * nq + j) + fr) * 272 + (32 * ks + 8 * fq) * 2);
            f32x4 a1[2];
            {
                bf16x8 wf[4];
#pragma unroll
                for (int ks = 0; ks < 4; ++ks) wf[ks] = *(const bf16x8*)(Wn + (cu * 64 + 16 * cm + fr) * 128 + 32 * ks + 8 * fq);
#pragma unroll
                for (int j = 0; j < 2; ++j) {
                    const u32x2 uu = *(const u32x2*)(UT + (cu * 128 + nh * 64 + 16 * (2 * nq + j) + fr) * 64 + 16 * cm + 4 * fq);
                    a1[j] = (f32x4){bflo(uu[0]), bfhi(uu[0]), bflo(uu[1]), bfhi(uu[1])};
#pragma unroll
                    for (int ks = 0; ks < 4; ++ks) a1[j] = __builtin_amdgcn_mfma_f32_16x16x32_bf16(wf[ks], sf[j][ks], a1[j], 0, 0, 0);
                    u32x2 t; t[0] = pk2(a1[j][0], a1[j][1]); t[1] = pk2(a1[j][2], a1[j][3]);
                    *(u32x2*)(Vt + (16 * (2 * nq + j) + fr) * 144 + (16 * cm + 4 * fq) * 2) = t;
                }
            }
            __syncthreads();
            bf16x8 vf[2][2];
#pragma unroll
            for (int j = 0; j < 2; ++j)
#pragma unroll
                for (int k2 = 0; k2 < 2; ++k2) vf[j][k2] = *(const bf16x8*)(Vt + (16 * (2 * nq + j) + fr) * 144 + (32 * k2 + 8 * fq) * 2);
            {
                bf16x8 qf[4], af[2];
#pragma unroll
                for (int ks = 0; ks < 4; ++ks) qf[ks] = *(const bf16x8*)(Qd + (cu * 64 + 16 * cm + fr) * 128 + 32 * ks + 8 * fq);
#pragma unroll
                for (int k2 = 0; k2 < 2; ++k2) af[k2] = *(const bf16x8*)(At + (cu * 64 + 16 * cm + fr) * 64 + 32 * k2 + 8 * fq);
#pragma unroll
                for (int j = 0; j < 2; ++j) {
                    f32x4 a2 = (f32x4){0.f, 0.f, 0.f, 0.f};
#pragma unroll
                    for (int ks = 0; ks < 4; ++ks) a2 = __builtin_amdgcn_mfma_f32_16x16x32_bf16(sf[j][ks], qf[ks], a2, 0, 0, 0);
#pragma unroll
                    for (int k2 = 0; k2 < 2; ++k2) a2 = __builtin_amdgcn_mfma_f32_16x16x32_bf16(vf[j][k2], af[k2], a2, 0, 0, 0);
                    *(f32x4*)(O + (size_t)(b * SEQ + n * 64 + 16 * cm + fr) * DM + h * 128 + nh * 64 + 16 * (2 * nq + j) + 4 * fq) = a2;
                }
            }
            {
                const float eg = egl[cu];
#pragma unroll
                for (int d2 = 0; d2 < 2; ++d2) {
                    bf16x8 kf[2];
#pragma unroll
                    for (int k2 = 0; k2 < 2; ++k2) kf[k2] = *(const bf16x8*)(KdT + (cu * 128 + 16 * (2 * cm + d2) + fr) * 64 + 32 * k2 + 8 * fq);
#pragma unroll
                    for (int j = 0; j < 2; ++j) {
                        sacc[d2][j] = sacc[d2][j] * eg;
#pragma unroll
                        for (int k2 = 0; k2 < 2; ++k2) sacc[d2][j] = __builtin_amdgcn_mfma_f32_16x16x32_bf16(kf[k2], vf[j][k2], sacc[d2][j], 0, 0, 0);
                        u32x2 t; t[0] = pk2(sacc[d2][j][0], sacc[d2][j][1]); t[1] = pk2(sacc[d2][j][2], sacc[d2][j][3]);
                        *(u32x2*)(St + (16 * (2 * nq + j) + fr) * 272 + (16 * (2 * cm + d2) + 4 * fq) * 2) = t;
                    }
                }
            }
            __syncthreads();
        }
    }
}

__device__ __forceinline__ Params launder(const Params& p) {
    Params q = p;
    asm volatile("" : "+s"(q.x), "+s"(q.c), "+s"(q.ada_w), "+s"(q.ada_b), "+s"(q.norm_w), "+s"(q.conv_in_w), "+s"(q.conv_w), "+s"(q.conv_out_w), "+s"(q.gdn_in_w), "+s"(q.gdn_conv_w));
    asm volatile("" : "+s"(q.gdn_a_log), "+s"(q.gdn_dt_bias), "+s"(q.gdn_norm_w), "+s"(q.gdn_out_w), "+s"(q.moe_group_w), "+s"(q.moe_group_b), "+s"(q.moe_expert_w), "+s"(q.moe_expert_b));
    asm volatile("" : "+s"(q.moe_w_gate), "+s"(q.moe_w_up), "+s"(q.moe_w_down), "+s"(q.sh_w_gate), "+s"(q.sh_w_up), "+s"(q.sh_w_down), "+s"(q.sh_gate_w), "+s"(q.out), "+s"(q.ws));
    return q;
}
#define WS_BF(off) ((bf16_t*)(q.ws + (off)))
#define PH(n, ...) if (p.ph_lo <= (n) && (n) < p.ph_hi) { { const Params q = launder(p); __VA_ARGS__; } if ((n) + 1 < p.ph_hi) grid.sync(); }
__global__ void __launch_bounds__(NT) mega_fwd(Params p) {
    __shared__ __attribute__((aligned(16))) unsigned char lds[LDS_BYTES];
    cg::grid_group grid = cg::this_grid();
    PH(0, phase_prologue(q, lds))
    PH(1, phase_h0(q))
    PH(2, phase_gemm_convin(q, lds))
    PH(3, phase_conv(q))
    PH(4, phase_gemm_plain(q, lds, WS_BF(WS_HA), WS_BF(WS_W_CONVOUT), 4, 1024, WS_BF(R_YO), 1024, 0))
    PH(5, phase_post_mixer(q, lds, 0))
    PH(6, phase_moe_gu(q, lds, 0))
    PH(7, phase_moe_down(q, lds, 0))
    PH(8, phase_post_moe(q, lds, 0, false))
    PH(9, phase_gemm_plain(q, lds, WS_BF(WS_HA), WS_BF(WS_W_GDNIN), 16, 1024, WS_BF(R_PLANES), 1024, 1))
    PH(10, phase_gdn_prep(q, lds))
    PH(11, phase_gdn_scan(q, lds))
    PH(12, phase_gdn_gate(q))
    PH(13, phase_gemm_plain(q, lds, WS_BF(WS_HA), WS_BF(WS_W_GDNOUT), 4, 1024, WS_BF(R_YO), 1024, 0))
    PH(14, phase_post_mixer(q, lds, 1))
    PH(15, phase_moe_gu(q, lds, 1))
    PH(16, phase_moe_down(q, lds, 1))
    PH(17, phase_post_moe(q, lds, 1, true))
}

extern "C" void kernel_launch(void* const* d_in, const int* in_sizes, int n_in, void* d_out, int out_size, void* d_ws, size_t ws_size, hipStream_t stream) {
    static int grid_blocks = 0;
    if (!grid_blocks) {
        int dev = 0, cus = 0, per_cu = 0;
        hipGetDevice(&dev);
        hipDeviceGetAttribute(&cus, hipDeviceAttributeMultiprocessorCount, dev);
        hipOccupancyMaxActiveBlocksPerMultiprocessor(&per_cu, mega_fwd, NT, 0);
        if (per_cu < 1) { fprintf(stderr, "kernel_launch: occupancy query says %d blocks per CU\n", per_cu); per_cu = 1; }
        grid_blocks = cus;
        if (ws_size < WS_END) fprintf(stderr, "kernel_launch: workspace too small: %zu < %zu\n", ws_size, (size_t)WS_END);
    }
    Params p{};
    const float** f = (const float**)&p;
    for (int i = 0; i < 25; ++i) f[i] = (const float*)d_in[i];
    p.out = (float*)d_out; p.ws = (unsigned char*)d_ws;
    hipMemsetAsync((char*)d_ws + WS_CTL, 0, 65536, stream);
#if N_LAUNCH_MODE
    for (int ph = 0; ph < NPHASE; ++ph) {
        p.ph_lo = ph; p.ph_hi = ph + 1;
        hipLaunchKernelGGL(mega_fwd, dim3(grid_blocks), dim3(NT), 0, stream, p);
    }
#else
    p.ph_lo = 0; p.ph_hi = NPHASE;
    void* args[] = {&p};
    hipError_t e = hipLaunchCooperativeKernel((void*)mega_fwd, dim3(grid_blocks), dim3(NT), args, 0, stream);
    if (e != hipSuccess) fprintf(stderr, "cooperative launch failed: %s (grid %d)\n", hipGetErrorString(e), grid_blocks);
#endif
}
```

```cpp
#include <hip/hip_runtime.h>
#include <hip/hip_cooperative_groups.h>
#include <cstdio>
#include <cstdint>
namespace cg = cooperative_groups;

typedef unsigned short bf16_t;
typedef short bf16x8 __attribute__((ext_vector_type(8)));
typedef float f32x4 __attribute__((ext_vector_type(4)));
typedef unsigned u32x4 __attribute__((ext_vector_type(4)));
typedef unsigned u32x2 __attribute__((ext_vector_type(2)));

#ifndef N_LAUNCH_MODE
#define N_LAUNCH_MODE 0
#endif

constexpr int NT = 512;
constexpr int NTOK = 16384, DM = 1024, SEQ = 4096;
constexpr float EPS = 1e-6f;
constexpr int LDS_BYTES = 147456;
constexpr int NPHASE = 18;

constexpr size_t MiB = 1048576;
constexpr size_t WS_CTL    = 0;
constexpr size_t WS_MOD    = 65536;
constexpr size_t WS_GATES  = WS_MOD + 196608;
constexpr size_t WS_SG     = WS_GATES + 131072;
constexpr size_t WS_EGL    = WS_SG + 65536;
constexpr size_t WS_BA     = 1 * MiB;
constexpr size_t WS_LIST   = 2 * MiB;
constexpr size_t WS_W_CONVIN  = 6 * MiB;
constexpr size_t WS_W_CONVOUT = 12 * MiB;
constexpr size_t WS_W_GDNIN   = 14 * MiB;
constexpr size_t WS_W_GDNOUT  = 22 * MiB;
constexpr size_t WS_W_SHGU    = 24 * MiB;
constexpr size_t WS_W_SHD     = 28 * MiB;
constexpr size_t WS_W_MOEGU   = 30 * MiB;
constexpr size_t WS_W_MOED    = 94 * MiB;
constexpr size_t WS_HA        = 126 * MiB;
constexpr size_t WS_R         = 158 * MiB;
constexpr size_t R_PLANES = WS_R;
constexpr size_t R_O      = WS_R;
constexpr size_t R_WN     = WS_R + 128 * MiB;
constexpr size_t R_QD     = WS_R + 160 * MiB;
constexpr size_t R_KDT    = WS_R + 192 * MiB;
constexpr size_t R_UT     = WS_R + 224 * MiB;
constexpr size_t R_AT     = WS_R + 256 * MiB;
constexpr size_t R_YO     = WS_R + 128 * MiB;
constexpr size_t R_B      = WS_R;
constexpr size_t R_U      = WS_R + 32 * MiB;
constexpr size_t R_HIDR   = WS_R;
constexpr size_t R_HIDS   = WS_R + 32 * MiB;
constexpr size_t R_YBUF   = WS_R + 160 * MiB;
constexpr size_t WS_END   = WS_R + 272 * MiB;

struct Params {
    const float* x; const float* c; const float* ada_w; const float* ada_b; const float* norm_w;
    const float* conv_in_w; const float* conv_w; const float* conv_out_w;
    const float* gdn_in_w; const float* gdn_conv_w; const float* gdn_a_log; const float* gdn_dt_bias; const float* gdn_norm_w; const float* gdn_out_w;
    const float* moe_group_w; const float* moe_group_b; const float* moe_expert_w; const float* moe_expert_b;
    const float* moe_w_gate; const float* moe_w_up; const float* moe_w_down;
    const float* sh_w_gate; const float* sh_w_up; const float* sh_w_down; const float* sh_gate_w;
    float* out; unsigned char* ws; int ph_lo, ph_hi;
};

__device__ __forceinline__ int otid() { int t = threadIdx.x; asm volatile("" : "+v"(t)); return t; }
__device__ __forceinline__ int oblk() { int t = blockIdx.x; asm volatile("" : "+s"(t)); return t; }
__device__ __forceinline__ int ogrid() { int t = gridDim.x; asm volatile("" : "+s"(t)); return t; }
__device__ __forceinline__ unsigned f2bf(float f) { unsigned u = __float_as_uint(f); return (u + 0x7fffu + ((u >> 16) & 1u)) >> 16; }
__device__ __forceinline__ unsigned pk2(float lo, float hi) { return f2bf(lo) | (f2bf(hi) << 16); }
__device__ __forceinline__ float bflo(unsigned w) { return __uint_as_float(w << 16); }
__device__ __forceinline__ float bfhi(unsigned w) { return __uint_as_float(w & 0xffff0000u); }
__device__ __forceinline__ float wave_sum(float v) {
#pragma unroll
    for (int o = 32; o; o >>= 1) v += __shfl_xor(v, o);
    return v;
}
__device__ __forceinline__ float siluf(float x) { return x / (1.f + __expf(-x)); }
__device__ __forceinline__ float sigmf(float x) { return 1.f / (1.f + __expf(-x)); }

__device__ __forceinline__ void ld_row_f32(const float* row, int lane, float (&v)[16]) {
#pragma unroll
    for (int j = 0; j < 4; ++j) { const f32x4 t = *(const f32x4*)(row + 256 * j + 4 * lane); v[4 * j] = t[0]; v[4 * j + 1] = t[1]; v[4 * j + 2] = t[2]; v[4 * j + 3] = t[3]; }
}
__device__ __forceinline__ void ld_row_bf16(const bf16_t* row, int lane, float (&v)[16]) {
#pragma unroll
    for (int j = 0; j < 4; ++j) { const u32x2 t = *(const u32x2*)(row + 256 * j + 4 * lane); v[4 * j] = bflo(t[0]); v[4 * j + 1] = bfhi(t[0]); v[4 * j + 2] = bflo(t[1]); v[4 * j + 3] = bfhi(t[1]); }
}
__device__ __forceinline__ void st_row_f32(float* row, int lane, const float (&v)[16]) {
#pragma unroll
    for (int j = 0; j < 4; ++j) { f32x4 t; t[0] = v[4 * j]; t[1] = v[4 * j + 1]; t[2] = v[4 * j + 2]; t[3] = v[4 * j + 3]; *(f32x4*)(row + 256 * j + 4 * lane) = t; }
}
__device__ __forceinline__ void st_row_bf16(bf16_t* row, int lane, const float (&v)[16]) {
#pragma unroll
    for (int j = 0; j < 4; ++j) { u32x2 t; t[0] = pk2(v[4 * j], v[4 * j + 1]); t[1] = pk2(v[4 * j + 2], v[4 * j + 3]); *(u32x2*)(row + 256 * j + 4 * lane) = t; }
}
__device__ __forceinline__ float sumsq16(const float (&v)[16]) {
    float s = 0.f;
#pragma unroll
    for (int i = 0; i < 16; ++i) s += v[i] * v[i];
    return s;
}

struct TJob { const float* s0; const float* s1; bf16_t* dst; int K, Nd, ld, type, tpg, ngroups; long sstride, dstride; };
__device__ __forceinline__ const float* tjob_src(const TJob& j, const float* s0, const float* s1, int r) {
    if (j.type == 0) return s0 + r;
    if (j.type == 1) { if (r < 1024) return s0 + r; const int rr = r - 1024, blk = rr >> 5, hi = (rr >> 4) & 1; return s0 + 1024 + hi * 1024 + 16 * blk + (rr & 15); }
    const int blk = r >> 5, hi = (r >> 4) & 1; return (hi ? s1 : s0) + 16 * blk + (r & 15);
}
__device__ __forceinline__ void transpose_tile(float* tl, const TJob& j, int tile) {
    const int tid = otid();
    const int g = tile / j.tpg, tt = tile % j.tpg;
    const int nkt = j.K >> 6;
    const int r0 = (tt / nkt) * 64, k0 = (tt % nkt) * 64;
    const float* s0 = j.s0 + (long)g * j.sstride; const float* s1 = j.s1 ? j.s1 + (long)g * j.sstride : nullptr;
    bf16_t* dst = j.dst + (long)g * j.dstride;
    {
        const int rq = tid & 15, kk = tid >> 4;
        const float* sp = tjob_src(j, s0, s1, r0 + 4 * rq);
#pragma unroll
        for (int i = 0; i < 2; ++i) { const int k = kk + 32 * i; const f32x4 v = *(const f32x4*)(sp + (long)(k0 + k) * j.ld); *(f32x4*)(tl + k * 68 + 4 * rq) = v; }
    }
    __syncthreads();
    {
        const int r = tid >> 3, ks = (tid & 7) * 8;
        float v[8];
#pragma unroll
        for (int i = 0; i < 8; ++i) v[i] = tl[(ks + i) * 68 + r];
        u32x4 w; w[0] = pk2(v[0], v[1]); w[1] = pk2(v[2], v[3]); w[2] = pk2(v[4], v[5]); w[3] = pk2(v[6], v[7]);
        *(u32x4*)(dst + (long)(r0 + r) * j.K + k0 + ks) = w;
    }
    __syncthreads();
}
__device__ __forceinline__ void tjob_set(TJob* j, const float* s0, const float* s1, bf16_t* dst, int K, int Nd, int ld, int type, int ngroups, long sstride, long dstride) {
    j->s0 = s0; j->s1 = s1; j->dst = dst; j->K = K; j->Nd = Nd; j->ld = ld; j->type = type; j->tpg = (Nd >> 6) * (K >> 6); j->ngroups = ngroups; j->sstride = sstride; j->dstride = dstride;
}
__device__ __forceinline__ void run_tjobs(unsigned char* lds, int nj, int brel, int nb) {
    TJob* jobs = (TJob*)lds; float* tl = (float*)(lds + 4096);
    int base = 0;
    for (int q = 0; q < nj; ++q) {
        const TJob j = jobs[q];
        const int nt = j.tpg * j.ngroups;
        int first = (brel - base % nb + nb) % nb;
        for (int t = first; t < nt; t += nb) transpose_tile(tl, j, t);
        base += nt;
    }
}
__device__ __forceinline__ void moe_weight_jobs(const Params& p, int layer, TJob* jobs) {
    bf16_t* wgu = (bf16_t*)(p.ws + WS_W_MOEGU); bf16_t* wd = (bf16_t*)(p.ws + WS_W_MOED);
    const long lo = (long)layer * 64 * 1024 * 256;
    tjob_set(jobs + 0, p.moe_w_gate + lo, p.moe_w_up + lo, wgu, 1024, 512, 256, 2, 64, 1024L * 256, 512L * 1024);
    tjob_set(jobs + 1, p.moe_w_down + lo, nullptr, wd, 256, 1024, 1024, 0, 64, 256L * 1024, 1024L * 256);
}

__device__ __forceinline__ void phase_prologue(const Params& p, unsigned char* lds) {
    const int tid = otid();
    for (int u = oblk(); u < 192; u += ogrid()) {
        float* cs = (float*)lds; float* red = (float*)(lds + 16384);
        for (int i = tid; i < 4096; i += NT) cs[i] = siluf(p.c[i]);
        __syncthreads();
        const int l = u / 96, cgp = u % 96, col = tid & 63, kg = tid >> 6;
        const float* w = p.ada_w + (size_t)l * 1024 * 6144 + cgp * 64 + col;
        float a0 = 0.f, a1 = 0.f, a2 = 0.f, a3 = 0.f;
#pragma unroll 8
        for (int k = kg; k < 1024; k += 8) { const float wv = w[(size_t)k * 6144]; a0 += cs[k] * wv; a1 += cs[1024 + k] * wv; a2 += cs[2048 + k] * wv; a3 += cs[3072 + k] * wv; }
        red[(kg * 4 + 0) * 64 + col] = a0; red[(kg * 4 + 1) * 64 + col] = a1; red[(kg * 4 + 2) * 64 + col] = a2; red[(kg * 4 + 3) * 64 + col] = a3;
        __syncthreads();
        if (tid < 256) {
            const int b = tid >> 6; float s = 0.f;
#pragma unroll
            for (int g = 0; g < 8; ++g) s += red[(g * 4 + b) * 64 + col];
            float* mod = (float*)(p.ws + WS_MOD);
            mod[(l * 4 + b) * 6144 + cgp * 64 + col] = s + p.ada_b[l * 6144 + cgp * 64 + col];
        }
        __syncthreads();
    }
    TJob* jobs = (TJob*)lds;
    if (tid == 0) {
        unsigned char* ws = p.ws;
        tjob_set(jobs + 0, p.conv_in_w, nullptr, (bf16_t*)(ws + WS_W_CONVIN), 1024, 3072, 3072, 1, 1, 0, 0);
        tjob_set(jobs + 1, p.conv_out_w, nullptr, (bf16_t*)(ws + WS_W_CONVOUT), 1024, 1024, 1024, 0, 1, 0, 0);
        tjob_set(jobs + 2, p.gdn_in_w, nullptr, (bf16_t*)(ws + WS_W_GDNIN), 1024, 4096, 4112, 0, 1, 0, 0);
        tjob_set(jobs + 3, p.gdn_out_w, nullptr, (bf16_t*)(ws + WS_W_GDNOUT), 1024, 1024, 1024, 0, 1, 0, 0);
        tjob_set(jobs + 4, p.sh_w_gate, p.sh_w_up, (bf16_t*)(ws + WS_W_SHGU), 1024, 1024, 512, 2, 2, 1024L * 512, 1024L * 1024);
        tjob_set(jobs + 5, p.sh_w_down, nullptr, (bf16_t*)(ws + WS_W_SHD), 512, 1024, 1024, 0, 2, 512L * 1024, 1024L * 512);
        moe_weight_jobs(p, 0, jobs + 6);
    }
    __syncthreads();
    run_tjobs(lds, 8, oblk(), ogrid());
}

struct ColP { float v[16]; };
__device__ __forceinline__ void ld_colp(const float* base, int lane, ColP& c) { ld_row_f32(base, lane, c.v); }
__device__ __forceinline__ const float* modp(const Params& p, int l, int b, int chunk) { return (const float*)(p.ws + WS_MOD) + (l * 4 + b) * 6144 + chunk * 1024; }

__device__ __forceinline__ void phase_h0(const Params& p) {
    const int lane = otid() & 63, wid = otid() >> 6;
    bf16_t* hA = (bf16_t*)(p.ws + WS_HA);
    ColP nw; ld_colp(p.norm_w + 0, lane, nw);
    for (int tok = oblk() * 8 + wid; tok < NTOK; tok += ogrid() * 8) {
        const int b = tok >> 12;
        float v[16]; ld_row_f32(p.x + (size_t)tok * DM, lane, v);
        const float r = rsqrtf(wave_sum(sumsq16(v)) * (1.f / DM) + EPS);
        ColP sc, sh; ld_colp(modp(p, 0, b, 1), lane, sc); ld_colp(modp(p, 0, b, 0), lane, sh);
#pragma unroll
        for (int i = 0; i < 16; ++i) v[i] = v[i] * r * nw.v[i] * (1.f + sc.v[i]) + sh.v[i];
        st_row_bf16(hA + (size_t)tok * DM, lane, v);
    }
}

__device__ __forceinline__ void phase_conv(const Params& p) {
    const int lane = otid() & 63, wid = otid() >> 6;
    const bf16_t* Bb = (const bf16_t*)(p.ws + R_B); const bf16_t* Ub = (const bf16_t*)(p.ws + R_U);
    bf16_t* hA = (bf16_t*)(p.ws + WS_HA);
    ColP w0, w1, w2; ld_colp(p.conv_w, lane, w0); ld_colp(p.conv_w + 1024, lane, w1); ld_colp(p.conv_w + 2048, lane, w2);
    for (int tok = oblk() * 8 + wid; tok < NTOK; tok += ogrid() * 8) {
        const int t = tok & (SEQ - 1);
        float bb[16], u0[16], u1[16], u2[16];
        ld_row_bf16(Bb + (size_t)tok * DM, lane, bb);
        ld_row_bf16(Ub + (size_t)tok * DM, lane, u2);
        if (t >= 1) ld_row_bf16(Ub + (size_t)(tok - 1) * DM, lane, u1); else {
#pragma unroll
            for (int i = 0; i < 16; ++i) u1[i] = 0.f; }
        if (t >= 2) ld_row_bf16(Ub + (size_t)(tok - 2) * DM, lane, u0); else {
#pragma unroll
            for (int i = 0; i < 16; ++i) u0[i] = 0.f; }
        float y[16];
#pragma unroll
        for (int i = 0; i < 16; ++i) y[i] = bb[i] * (w0.v[i] * u0[i] + w1.v[i] * u1[i] + w2.v[i] * u2[i]);
        st_row_bf16(hA + (size_t)tok * DM, lane, y);
    }
}

template <int NCT, class BF>
__device__ __forceinline__ void smalln_gemm(const float* Hs, float* Ps, int wid, int lane, const BF& bf) {
    f32x4 acc[NCT];
#pragma unroll
    for (int c = 0; c < NCT; ++c) acc[c] = (f32x4){0.f, 0.f, 0.f, 0.f};
    const int row = lane & 15, kq = lane >> 4;
    const float* hrow = Hs + row * 1026 + 128 * wid + kq;
#pragma unroll 4
    for (int s = 0; s < 32; ++s) {
        const float a = hrow[4 * s];
        const int k = 128 * wid + 4 * s + kq;
#pragma unroll
        for (int c = 0; c < NCT; ++c) acc[c] = __builtin_amdgcn_mfma_f32_16x16x4f32(a, bf(k, c, row), acc[c], 0, 0, 0);
    }
#pragma unroll
    for (int c = 0; c < NCT; ++c)
#pragma unroll
        for (int r = 0; r < 4; ++r) Ps[(wid * 16 + 4 * kq + r) * (NCT * 16) + c * 16 + row] = acc[c][r];
}

struct RouteB {
    const float* we; const float* wg; const float* wsg;
    __device__ __forceinline__ float operator()(int k, int ct, int c16) const {
        if (ct < 4) return we[k * 64 + ct * 16 + c16];
        if (c16 < 8) return wg[k * 8 + c16];
        if (c16 == 8) return wsg[k];
        return 0.f;
    }
};
struct BaB { const float* w; __device__ __forceinline__ float operator()(int k, int, int c16) const { return w[(size_t)k * 4112 + 4096 + c16]; } };

__device__ __forceinline__ void phase_post_mixer(const Params& p, unsigned char* lds, int l) {
    const int tid = otid(), lane = tid & 63, wid = tid >> 6;
    float* Hs = (float*)lds;
    float* Ps = (float*)(lds + 65792);
    float* Lg = (float*)(lds + 65792 + 40960);
    const float* xin = (l == 0) ? p.x : p.out;
    const bf16_t* yo = (const bf16_t*)(p.ws + R_YO);
    bf16_t* hA = (bf16_t*)(p.ws + WS_HA);
    int* cnt = (int*)(p.ws + WS_CTL) + l * 64;
    int* list = (int*)(p.ws + WS_LIST);
    float* gates = (float*)(p.ws + WS_GATES); float* sgt = (float*)(p.ws + WS_SG);
    ColP nw1, nw2; ld_colp(p.norm_w + (l * 4 + 1) * 1024, lane, nw1); ld_colp(p.norm_w + (l * 4 + 2) * 1024, lane, nw2);
    RouteB rb; rb.we = p.moe_expert_w + (size_t)l * 1024 * 64; rb.wg = p.moe_group_w + (size_t)l * 1024 * 8; rb.wsg = p.sh_gate_w + (size_t)l * 1024;
    for (int g16 = oblk(); g16 < NTOK / 16; g16 += ogrid()) {
#pragma unroll 1
        for (int q = 0; q < 2; ++q) {
            const int tl = wid * 2 + q, tok = g16 * 16 + tl, b = tok >> 12;
            float xv[16], yv[16];
            ld_row_f32(xin + (size_t)tok * DM, lane, xv); ld_row_bf16(yo + (size_t)tok * DM, lane, yv);
            const float r1 = rsqrtf(wave_sum(sumsq16(yv)) * (1.f / DM) + EPS);
            ColP gt; ld_colp(modp(p, l, b, 2), lane, gt);
#pragma unroll
            for (int i = 0; i < 16; ++i) xv[i] = xv[i] + gt.v[i] * (yv[i] * r1 * nw1.v[i]);
            st_row_f32(p.out + (size_t)tok * DM, lane, xv);
            const float r2 = rsqrtf(wave_sum(sumsq16(xv)) * (1.f / DM) + EPS);
            ColP sc, sh; ld_colp(modp(p, l, b, 4), lane, sc); ld_colp(modp(p, l, b, 3), lane, sh);
#pragma unroll
            for (int i = 0; i < 16; ++i) xv[i] = xv[i] * r2 * nw2.v[i] * (1.f + sc.v[i]) + sh.v[i];
            st_row_bf16(hA + (size_t)tok * DM, lane, xv);
#pragma unroll
            for (int j = 0; j < 4; ++j)
#pragma unroll
                for (int i = 0; i < 4; ++i) Hs[tl * 1026 + 256 * j + 4 * lane + i] = xv[4 * j + i];
        }
        __syncthreads();
        smalln_gemm<5>(Hs, Ps, wid, lane, rb);
        __syncthreads();
        for (int i = tid; i < 16 * 80; i += NT) { float s = 0.f;
#pragma unroll
            for (int w = 0; w < 8; ++w) s += Ps[w * 1280 + i];
            Lg[i] = s; }
        __syncthreads();
        if (tid < 16) {
            const int tok = g16 * 16 + tid; const float* lg = Lg + tid * 80;
            float gl[8]; float gm = -3.4e38f; int gs = 0;
#pragma unroll
            for (int g = 0; g < 8; ++g) { gl[g] = lg[64 + g] + p.moe_group_b[l * 8 + g]; if (gl[g] > gm) { gm = gl[g]; gs = g; } }
            float den = 0.f;
#pragma unroll
            for (int g = 0; g < 8; ++g) den += __expf(gl[g] - gm);
            const float psel = 1.f / den;
            float el[8];
#pragma unroll
            for (int j = 0; j < 8; ++j) el[j] = lg[gs * 8 + j] + p.moe_expert_b[l * 64 + gs * 8 + j];
            float v1 = -3.4e38f; int i1 = 0;
#pragma unroll
            for (int j = 0; j < 8; ++j) if (el[j] > v1) { v1 = el[j]; i1 = j; }
            float v2 = -3.4e38f; int i2 = 0;
#pragma unroll
            for (int j = 0; j < 8; ++j) if (j != i1 && el[j] > v2) { v2 = el[j]; i2 = j; }
            const float e2 = __expf(v2 - v1);
            const float g1 = psel / (1.f + e2), g2 = psel * e2 / (1.f + e2);
            const int e1id = gs * 8 + i1, e2id = gs * 8 + i2;
            gates[tok * 2] = g1; gates[tok * 2 + 1] = g2; sgt[tok] = sigmf(lg[72]);
            const int p1 = atomicAdd(&cnt[e1id], 1); list[e1id * NTOK + p1] = tok * 2;
            const int p2 = atomicAdd(&cnt[e2id], 1); list[e2id * NTOK + p2] = tok * 2 + 1;
        }
        __syncthreads();
    }
}

__device__ __forceinline__ void phase_post_moe(const Params& p, unsigned char* lds, int l, bool final) {
    const int tid = otid(), lane = tid & 63, wid = tid >> 6;
    float* Hs = (float*)lds; float* Ps = (float*)(lds + 65792);
    const bf16_t* yb = (const bf16_t*)(p.ws + R_YBUF);
    bf16_t* hA = (bf16_t*)(p.ws + WS_HA);
    float* ba = (float*)(p.ws + WS_BA);
    ColP nw3, nwn; ld_colp(p.norm_w + (l * 4 + 3) * 1024, lane, nw3);
    if (!final) ld_colp(p.norm_w + ((l + 1) * 4 + 0) * 1024, lane, nwn);
    BaB bb; bb.w = p.gdn_in_w;
    for (int g16 = oblk(); g16 < NTOK / 16; g16 += ogrid()) {
#pragma unroll 1
        for (int q = 0; q < 2; ++q) {
            const int tl = wid * 2 + q, tok = g16 * 16 + tl, b = tok >> 12;
            float xv[16], yv[16], t1[16];
            ld_row_f32(p.out + (size_t)tok * DM, lane, xv);
            ld_row_bf16(yb + (size_t)tok * DM, lane, yv);
            ld_row_bf16(yb + (size_t)(NTOK + tok) * DM, lane, t1);
#pragma unroll
            for (int i = 0; i < 16; ++i) yv[i] += t1[i];
            ld_row_bf16(yb + (size_t)(2 * NTOK + tok) * DM, lane, t1);
#pragma unroll
            for (int i = 0; i < 16; ++i) yv[i] += t1[i];
            const float r1 = rsqrtf(wave_sum(sumsq16(yv)) * (1.f / DM) + EPS);
            ColP gt; ld_colp(modp(p, l, b, 5), lane, gt);
#pragma unroll
            for (int i = 0; i < 16; ++i) xv[i] = xv[i] + gt.v[i] * (yv[i] * r1 * nw3.v[i]);
            st_row_f32(p.out + (size_t)tok * DM, lane, xv);
            if (!final) {
                const float r2 = rsqrtf(wave_sum(sumsq16(xv)) * (1.f / DM) + EPS);
                ColP sc, sh; ld_colp(modp(p, l + 1, b, 1), lane, sc); ld_colp(modp(p, l + 1, b, 0), lane, sh);
#pragma unroll
                for (int i = 0; i < 16; ++i) xv[i] = xv[i] * r2 * nwn.v[i] * (1.f + sc.v[i]) + sh.v[i];
                st_row_bf16(hA + (size_t)tok * DM, lane, xv);
#pragma unroll
                for (int j = 0; j < 4; ++j)
#pragma unroll
                    for (int i = 0; i < 4; ++i) Hs[tl * 1026 + 256 * j + 4 * lane + i] = xv[4 * j + i];
            }
        }
        if (!final) {
            __syncthreads();
            smalln_gemm<1>(Hs, Ps, wid, lane, bb);
            __syncthreads();
            if (tid < 256) { float s = 0.f;
#pragma unroll
                for (int w = 0; w < 8; ++w) s += Ps[w * 256 + tid];
                ba[(size_t)(g16 * 16) * 16 + tid] = s; }
            __syncthreads();
        }
    }
}

__device__ __forceinline__ void phase_gdn_gate(const Params& p) {
    const int lane = otid() & 63, wid = otid() >> 6;
    const float* o = (const float*)(p.ws + R_O);
    const bf16_t* z = (const bf16_t*)(p.ws + R_PLANES) + (size_t)3 * NTOK * DM;
    bf16_t* hA = (bf16_t*)(p.ws + WS_HA);
    float gw[16];
#pragma unroll
    for (int j = 0; j < 4; ++j)
#pragma unroll
        for (int i = 0; i < 4; ++i) gw[4 * j + i] = p.gdn_norm_w[(4 * lane + i) & 127];
    for (int tok = oblk() * 8 + wid; tok < NTOK; tok += ogrid() * 8) {
        float ov[16], zv[16];
        ld_row_f32(o + (size_t)tok * DM, lane, ov); ld_row_bf16(z + (size_t)tok * DM, lane, zv);
#pragma unroll
        for (int j = 0; j < 4; ++j) {
            float s = ov[4 * j] * ov[4 * j] + ov[4 * j + 1] * ov[4 * j + 1] + ov[4 * j + 2] * ov[4 * j + 2] + ov[4 * j + 3] * ov[4 * j + 3];
#pragma unroll
            for (int of = 16; of; of >>= 1) s += __shfl_xor(s, of);
            const float r = rsqrtf(s * (1.f / 128.f) + EPS);
#pragma unroll
            for (int i = 0; i < 4; ++i) ov[4 * j + i] = ov[4 * j + i] * r * gw[4 * j + i] * siluf(zv[4 * j + i]);
        }
        st_row_bf16(hA + (size_t)tok * DM, lane, ov);
    }
}

template <class Epi>
__device__ __forceinline__ void gemm_unit(unsigned char* lds, const bf16_t* A, const int* gidx, int gvalid, const bf16_t* Bt, int K, const Epi& E) {
    const int tid = otid(), wid = tid >> 6, lane = tid & 63, wr = wid >> 2, wc = wid & 3, fr = lane & 15, fq = lane >> 4;
    unsigned char* As = lds; unsigned char* Bs = lds + 256 * 80;
    const bf16_t* ap[2]; const bf16_t* bp[2]; int lo[2];
#pragma unroll
    for (int i = 0; i < 2; ++i) {
        const int pc = tid + 512 * i, row = pc >> 2, seg = pc & 3;
        long arow = row;
        if (gidx) arow = (long)(gidx[row < gvalid ? row : 0] >> 1);
        ap[i] = A + arow * K + seg * 8; bp[i] = Bt + (long)row * K + seg * 8; lo[i] = row * 80 + seg * 16;
    }
    f32x4 acc[2][2][4][2];
#pragma unroll
    for (int a = 0; a < 2; ++a)
#pragma unroll
        for (int b = 0; b < 2; ++b)
#pragma unroll
            for (int m = 0; m < 4; ++m)
#pragma unroll
                for (int n = 0; n < 2; ++n) acc[a][b][m][n] = (f32x4){0.f, 0.f, 0.f, 0.f};
    u32x4 ra[2], rb[2];
#pragma unroll
    for (int i = 0; i < 2; ++i) { ra[i] = *(const u32x4*)ap[i]; rb[i] = *(const u32x4*)bp[i]; }
    const int nk = K >> 5;
    for (int kt = 0; kt < nk; ++kt) {
        __syncthreads();
#pragma unroll
        for (int i = 0; i < 2; ++i) { *(u32x4*)(As + lo[i]) = ra[i]; *(u32x4*)(Bs + lo[i]) = rb[i]; }
        __syncthreads();
        if (kt + 1 < nk) {
#pragma unroll
            for (int i = 0; i < 2; ++i) { ra[i] = *(const u32x4*)(ap[i] + (kt + 1) * 32); rb[i] = *(const u32x4*)(bp[i] + (kt + 1) * 32); }
        }
        bf16x8 Af[2][4], Bf[2][2];
#pragma unroll
        for (int a = 0; a < 2; ++a)
#pragma unroll
            for (int m = 0; m < 4; ++m) Af[a][m] = *(const bf16x8*)(As + (128 * a + 64 * wr + 16 * m + fr) * 80 + fq * 16);
#pragma unroll
        for (int b = 0; b < 2; ++b)
#pragma unroll
            for (int n = 0; n < 2; ++n) Bf[b][n] = *(const bf16x8*)(Bs + (128 * b + 32 * wc + 16 * n + fr) * 80 + fq * 16);
#pragma unroll
        for (int a = 0; a < 2; ++a)
#pragma unroll
            for (int b = 0; b < 2; ++b)
#pragma unroll
                for (int m = 0; m < 4; ++m)
#pragma unroll
                    for (int n = 0; n < 2; ++n) acc[a][b][m][n] = __builtin_amdgcn_mfma_f32_16x16x32_bf16(Bf[b][n], Af[a][m], acc[a][b][m][n], 0, 0, 0);
    }
#pragma unroll
    for (int a = 0; a < 2; ++a)
#pragma unroll
        for (int b = 0; b < 2; ++b)
#pragma unroll
            for (int m = 0; m < 4; ++m) E(128 * a + 64 * wr + 16 * m + fr, 128 * b + 32 * wc + 4 * fq, acc[a][b][m][0], acc[a][b][m][1]);
    __syncthreads();
}

__device__ __forceinline__ void st4bf(bf16_t* p, const f32x4& v) { u32x2 t; t[0] = pk2(v[0], v[1]); t[1] = pk2(v[2], v[3]); *(u32x2*)p = t; }

struct EpiPlain { bf16_t* O; int ldc; int row0, col0;
    __device__ __forceinline__ void operator()(int r, int c, const f32x4& v0, const f32x4& v1) const {
        bf16_t* q = O + (size_t)(row0 + r) * ldc + col0 + c; st4bf(q, v0); st4bf(q + 16, v1); } };
struct EpiConvIn { bf16_t* Bb; bf16_t* Ub; int row0, pn;
    __device__ __forceinline__ void operator()(int r, int c, const f32x4& v0, const f32x4& v1) const {
        if (pn < 4) { bf16_t* q = Bb + (size_t)(row0 + r) * DM + pn * 256 + c; st4bf(q, v0); st4bf(q + 16, v1); }
        else { const int uc = (pn - 4) * 128 + (c >> 5) * 16 + (c & 15); f32x4 u = v0 * v1; st4bf(Ub + (size_t)(row0 + r) * DM + uc, u); } } };
struct EpiGU { bf16_t* H; int ldh; int row0, pn;
    __device__ __forceinline__ void operator()(int r, int c, const f32x4& v0, const f32x4& v1) const {
        f32x4 h; h[0] = siluf(v0[0]) * v1[0]; h[1] = siluf(v0[1]) * v1[1]; h[2] = siluf(v0[2]) * v1[2]; h[3] = siluf(v0[3]) * v1[3];
        st4bf(H + (size_t)(row0 + r) * ldh + pn * 128 + (c >> 5) * 16 + (c & 15), h); } };
struct EpiDownR { bf16_t* Y; const int* lst; const float* gates; int valid, pn;
    __device__ __forceinline__ void operator()(int r, int c, const f32x4& v0, const f32x4& v1) const {
        if (r < valid) { const int e = lst[r]; const float g = gates[e]; bf16_t* q = Y + ((size_t)(e & 1) * NTOK + (e >> 1)) * DM + pn * 256 + c; st4bf(q, v0 * g); st4bf(q + 16, v1 * g); } } };
struct EpiDownS { bf16_t* Y; const float* sg; int row0, pn;
    __device__ __forceinline__ void operator()(int r, int c, const f32x4& v0, const f32x4& v1) const {
        const float g = sg[row0 + r]; bf16_t* q = Y + (size_t)(row0 + r) * DM + pn * 256 + c; st4bf(q, v0 * g); st4bf(q + 16, v1 * g); } };

__device__ __forceinline__ void phase_gemm_convin(const Params& p, unsigned char* lds) {
    const bf16_t* A = (const bf16_t*)(p.ws + WS_HA); const bf16_t* Bt = (const bf16_t*)(p.ws + WS_W_CONVIN);
    for (int u = oblk(); u < 64 * 12; u += ogrid()) {
        const int pm = u / 12, pn = u % 12;
        EpiConvIn E; E.Bb = (bf16_t*)(p.ws + R_B); E.Ub = (bf16_t*)(p.ws + R_U); E.row0 = pm * 256; E.pn = pn;
        gemm_unit(lds, A + (size_t)pm * 256 * 1024, nullptr, 0, Bt + (size_t)pn * 256 * 1024, 1024, E);
    }
}
__device__ __forceinline__ void phase_gemm_plain(const Params& p, unsigned char* lds, const bf16_t* A, const bf16_t* Bt, int nN, int K, bf16_t* O, int ldc, int planes) {
    for (int u = oblk(); u < 64 * nN; u += ogrid()) {
        const int pm = u / nN, pn = u % nN;
        EpiPlain E; E.ldc = ldc; E.row0 = pm * 256;
        if (planes) { E.O = O + (size_t)(pn >> 2) * NTOK * DM; E.col0 = (pn & 3) * 256; } else { E.O = O; E.col0 = pn * 256; }
        gemm_unit(lds, A + (size_t)pm * 256 * K, nullptr, 0, Bt + (size_t)pn * 256 * K, K, E);
    }
}

__device__ __forceinline__ void moe_tiles(const Params& p, int l, int* ts) {
    if (otid() == 0) { const int* cnt = (const int*)(p.ws + WS_CTL) + l * 64; int s = 0; for (int e = 0; e < 64; ++e) { ts[e] = s; s += (cnt[e] + 255) >> 8; } ts[64] = s; }
    __syncthreads();
}
__device__ __forceinline__ void phase_moe_gu(const Params& p, unsigned char* lds, int l) {
    int* ts = (int*)(lds + 131072);
    moe_tiles(p, l, ts);
    const int* cnt = (const int*)(p.ws + WS_CTL) + l * 64; const int* list = (const int*)(p.ws + WS_LIST);
    const bf16_t* hA = (const bf16_t*)(p.ws + WS_HA);
    const int nr = ts[64] * 2, ns = 64 * 4;
    for (int u = oblk(); u < nr + ns; u += ogrid()) {
        if (u < nr) {
            const int mt = u >> 1, pn = u & 1; int e = 0;
            for (int q = 1; q < 64; ++q) if (ts[q] <= mt) e = q;
            const int base = (mt - ts[e]) * 256; const int valid = min(256, cnt[e] - base);
            EpiGU E; E.H = (bf16_t*)(p.ws + R_HIDR); E.ldh = 256; E.row0 = mt * 256; E.pn = pn;
            gemm_unit(lds, hA, list + (size_t)e * NTOK + base, valid, (const bf16_t*)(p.ws + WS_W_MOEGU) + ((size_t)e * 512 + pn * 256) * 1024, 1024, E);
        } else {
            const int v = u - nr, pm = v >> 2, pn = v & 3;
            EpiGU E; E.H = (bf16_t*)(p.ws + R_HIDS); E.ldh = 512; E.row0 = pm * 256; E.pn = pn;
            gemm_unit(lds, hA + (size_t)pm * 256 * 1024, nullptr, 0, (const bf16_t*)(p.ws + WS_W_SHGU) + ((size_t)l * 1024 + pn * 256) * 1024, 1024, E);
        }
    }
}
__device__ __forceinline__ void phase_moe_down(const Params& p, unsigned char* lds, int l) {
    int* ts = (int*)(lds + 131072);
    moe_tiles(p, l, ts);
    const int* cnt = (const int*)(p.ws + WS_CTL) + l * 64; const int* list = (const int*)(p.ws + WS_LIST);
    const int nr = ts[64] * 4, ns = 64 * 4;
    bf16_t* yb = (bf16_t*)(p.ws + R_YBUF);
    for (int u = oblk(); u < nr + ns; u += ogrid()) {
        if (u < nr) {
            const int mt = u >> 2, pn = u & 3; int e = 0;
            for (int q = 1; q < 64; ++q) if (ts[q] <= mt) e = q;
            const int base = (mt - ts[e]) * 256; const int valid = min(256, cnt[e] - base);
            EpiDownR E; E.Y = yb; E.lst = list + (size_t)e * NTOK + base; E.gates = (const float*)(p.ws + WS_GATES); E.valid = valid; E.pn = pn;
            gemm_unit(lds, (const bf16_t*)(p.ws + R_HIDR) + (size_t)mt * 256 * 256, nullptr, 0, (const bf16_t*)(p.ws + WS_W_MOED) + ((size_t)e * 1024 + pn * 256) * 256, 256, E);
        } else {
            const int v = u - nr, pm = v >> 2, pn = v & 3;
            EpiDownS E; E.Y = yb + (size_t)2 * NTOK * DM; E.sg = (const float*)(p.ws + WS_SG); E.row0 = pm * 256; E.pn = pn;
            gemm_unit(lds, (const bf16_t*)(p.ws + R_HIDS) + (size_t)pm * 256 * 512, nullptr, 0, (const bf16_t*)(p.ws + WS_W_SHD) + ((size_t)l * 1024 + pn * 256) * 512, 512, E);
        }
    }
}

__device__ __forceinline__ void phase_gdn_prep(const Params& p, unsigned char* lds) {
    unsigned char* Qs = lds;
    unsigned char* Ks = lds + 17408;
    float* RHS = (float*)(lds + 34816);
    float* Lm = (float*)(lds + 34816 + 65536);
    float* betas = (float*)(lds + 34816 + 65536 + 16384);
    float* gcs = betas + 64;
    const bf16_t* planes = (const bf16_t*)(p.ws + R_PLANES);
    const float* ba = (const float*)(p.ws + WS_BA);
    bf16_t* Wn = (bf16_t*)(p.ws + R_WN); bf16_t* Qd = (bf16_t*)(p.ws + R_QD); bf16_t* KdT = (bf16_t*)(p.ws + R_KDT); bf16_t* UT = (bf16_t*)(p.ws + R_UT); bf16_t* At = (bf16_t*)(p.ws + R_AT);
    float* egl = (float*)(p.ws + WS_EGL);
    for (int cu = oblk(); cu < 2048; cu += ogrid()) {
        const int tid = otid(), lane = tid & 63, wid = tid >> 6;
        const int n = cu & 63, h = (cu >> 6) & 7, b = cu >> 9;
        const int tok0 = b * SEQ + n * 64;
        if (wid == 0) {
            const float bb = ba[(size_t)(tok0 + lane) * 16 + h], aa = ba[(size_t)(tok0 + lane) * 16 + 8 + h];
            const float beta = sigmf(bb);
            const float xs = aa + p.gdn_dt_bias[h];
            const float sp = fmaxf(xs, 0.f) + log1pf(__expf(-fabsf(xs)));
            float g = -__expf(p.gdn_a_log[h]) * sp;
#pragma unroll
            for (int o = 1; o < 64; o <<= 1) { const float t = __shfl_up(g, o); if (lane >= o) g += t; }
            betas[lane] = beta; gcs[lane] = g;
            if (lane == 63) egl[cu] = __expf(g);
        }
        __syncthreads();
        const float glast = gcs[63];
        {
            const int r = tid >> 3, cs = (tid & 7) * 16;
            const float beta = betas[r], gc = gcs[r];
#pragma unroll 1
            for (int pl = 0; pl < 3; ++pl) {
                float a[16];
#pragma unroll
                for (int i = 0; i < 16; ++i) a[i] = 0.f;
                const int ch = pl * 1024 + h * 128 + cs;
#pragma unroll
                for (int j = 0; j < 4; ++j) {
                    const int tt = n * 64 + r - 3 + j;
                    if (tt >= 0) {
                        const bf16_t* src = planes + ((size_t)pl * NTOK + (size_t)(b * SEQ + tt)) * DM + h * 128 + cs;
                        const u32x4 w0 = *(const u32x4*)src, w1 = *(const u32x4*)(src + 8);
                        const float* cw = p.gdn_conv_w + j * 3072 + ch;
                        const f32x4 c0 = *(const f32x4*)cw, c1 = *(const f32x4*)(cw + 4), c2 = *(const f32x4*)(cw + 8), c3 = *(const f32x4*)(cw + 12);
                        a[0] += c0[0] * bflo(w0[0]); a[1] += c0[1] * bfhi(w0[0]); a[2] += c0[2] * bflo(w0[1]); a[3] += c0[3] * bfhi(w0[1]);
                        a[4] += c1[0] * bflo(w0[2]); a[5] += c1[1] * bfhi(w0[2]); a[6] += c1[2] * bflo(w0[3]); a[7] += c1[3] * bfhi(w0[3]);
                        a[8] += c2[0] * bflo(w1[0]); a[9] += c2[1] * bfhi(w1[0]); a[10] += c2[2] * bflo(w1[1]); a[11] += c2[3] * bfhi(w1[1]);
                        a[12] += c3[0] * bflo(w1[2]); a[13] += c3[1] * bfhi(w1[2]); a[14] += c3[2] * bflo(w1[3]); a[15] += c3[3] * bfhi(w1[3]);
                    }
                }
                float ss = 0.f;
#pragma unroll
                for (int i = 0; i < 16; ++i) { a[i] = siluf(a[i]); ss += a[i] * a[i]; }
#pragma unroll
                for (int o = 1; o < 8; o <<= 1) ss += __shfl_xor(ss, o);
                if (pl == 0) {
                    const float rq = rsqrtf(ss + EPS) * 0.08838834764831845f, eg = __expf(gc);
                    unsigned qw[8], qdw[8];
#pragma unroll
                    for (int i = 0; i < 8; ++i) { const float q0 = a[2 * i] * rq, q1 = a[2 * i + 1] * rq; qw[i] = pk2(q0, q1); qdw[i] = pk2(q0 * eg, q1 * eg); }
                    *(u32x4*)(Qs + r * 272 + cs * 2) = (u32x4){qw[0], qw[1], qw[2], qw[3]}; *(u32x4*)(Qs + r * 272 + cs * 2 + 16) = (u32x4){qw[4], qw[5], qw[6], qw[7]};
                    bf16_t* qd = Qd + ((size_t)cu * 64 + r) * 128 + cs;
                    *(u32x4*)qd = (u32x4){qdw[0], qdw[1], qdw[2], qdw[3]}; *(u32x4*)(qd + 8) = (u32x4){qdw[4], qdw[5], qdw[6], qdw[7]};
                } else if (pl == 1) {
                    const float rk = rsqrtf(ss + EPS), ekd = __expf(glast - gc), kb = beta * __expf(gc);
                    unsigned kw[8];
#pragma unroll
                    for (int i = 0; i < 8; ++i) {
                        const float k0 = a[2 * i] * rk, k1 = a[2 * i + 1] * rk; kw[i] = pk2(k0, k1);
                        RHS[r * 256 + 128 + cs + 2 * i] = k0 * kb; RHS[r * 256 + 128 + cs + 2 * i + 1] = k1 * kb;
                        KdT[((size_t)cu * 128 + cs + 2 * i) * 64 + r] = (bf16_t)f2bf(k0 * ekd);
                        KdT[((size_t)cu * 128 + cs + 2 * i + 1) * 64 + r] = (bf16_t)f2bf(k1 * ekd);
                    }
                    *(u32x4*)(Ks + r * 272 + cs * 2) = (u32x4){kw[0], kw[1], kw[2], kw[3]}; *(u32x4*)(Ks + r * 272 + cs * 2 + 16) = (u32x4){kw[4], kw[5], kw[6], kw[7]};
                } else {
#pragma unroll
                    for (int i = 0; i < 16; ++i) RHS[r * 256 + cs + i] = a[i] * beta;
                }
            }
        }
        __syncthreads();
        {
            const int ti = wid & 3, isq = wid >> 2, fr = lane & 15, fq = lane >> 4;
            const unsigned char* Xs = isq ? Qs : Ks;
            bf16x8 af[4];
#pragma unroll
            for (int ks = 0; ks < 4; ++ks) af[ks] = *(const bf16x8*)(Xs + (16 * ti + fr) * 272 + (32 * ks + 8 * fq) * 2);
#pragma unroll
            for (int tj = 0; tj < 4; ++tj) {
                if (tj <= ti) {
                    f32x4 acc = (f32x4){0.f, 0.f, 0.f, 0.f};
#pragma unroll
                    for (int ks = 0; ks < 4; ++ks) { const bf16x8 bfg = *(const bf16x8*)(Ks + (16 * tj + fr) * 272 + (32 * ks + 8 * fq) * 2); acc = __builtin_amdgcn_mfma_f32_16x16x32_bf16(af[ks], bfg, acc, 0, 0, 0); }
                    const int jj = 16 * tj + fr; const float gj = gcs[jj];
#pragma unroll
                    for (int rg = 0; rg < 4; ++rg) {
                        const int ii = 16 * ti + 4 * fq + rg; const float gi = gcs[ii];
                        if (isq) { const float v = (ii >= jj) ? acc[rg] * __expf(gi - gj) : 0.f; At[((size_t)cu * 64 + ii) * 64 + jj] = (bf16_t)f2bf(v); }
                        else { Lm[jj * 64 + ii] = (ii > jj) ? acc[rg] * betas[ii] * __expf(gi - gj) : 0.f; }
                    }
                } else if (isq) {
#pragma unroll
                    for (int rg = 0; rg < 4; ++rg) At[((size_t)cu * 64 + 16 * ti + 4 * fq + rg) * 64 + 16 * tj + fr] = 0;
                }
            }
        }
        __syncthreads();
        if (tid < 256) {
            const int tid = otid();
            float rr[64];
#pragma unroll
            for (int i = 0; i < 64; ++i) rr[i] = RHS[i * 256 + tid];
            const bool isu = tid < 128;
            bf16_t* op = isu ? UT + ((size_t)cu * 128 + tid) * 64 : Wn + (size_t)cu * 64 * 128 + (tid - 128);
            const int ostr = isu ? 1 : 128;
            const unsigned sgn = isu ? 0u : 0x80000000u;
#pragma unroll
            for (int j = 0; j < 64; ++j) {
                const float xj = rr[j];
#pragma unroll
                for (int i4 = (j + 1) / 4; i4 < 16; ++i4) {
                    const f32x4 lv = *(const f32x4*)(Lm + j * 64 + 4 * i4);
#pragma unroll
                    for (int q = 0; q < 4; ++q) if (4 * i4 + q > j) rr[4 * i4 + q] -= lv[q] * xj;
                }
                op[j * ostr] = (bf16_t)f2bf(__uint_as_float(__float_as_uint(xj) ^ sgn));
                asm volatile("" ::: "memory");
            }
        }
        __syncthreads();
    }
}

__device__ __forceinline__ void phase_gdn_scan(const Params& p, unsigned char* lds) {
    const int tid = otid(), lane = tid & 63, wid = tid >> 6, fr = lane & 15, fq = lane >> 4;
    if (oblk() >= 64) {
        if (ogrid() > 64) {
            TJob* jobs = (TJob*)lds;
            if (tid == 0) moe_weight_jobs(p, 1, jobs);
            __syncthreads();
            run_tjobs(lds, 2, oblk() - 64, ogrid() - 64);
        }
        return;
    }
    unsigned char* St = lds;
    unsigned char* Vt = lds + 17408;
    const bf16_t* Wn = (const bf16_t*)(p.ws + R_WN); const bf16_t* Qd = (const bf16_t*)(p.ws + R_QD); const bf16_t* KdT = (const bf16_t*)(p.ws + R_KDT);
    const bf16_t* UT = (const bf16_t*)(p.ws + R_UT); const bf16_t* At = (const bf16_t*)(p.ws + R_AT);
    const float* egl = (const float*)(p.ws + WS_EGL);
    float* O = (float*)(p.ws + R_O);
    const int cm = wid >> 1, nq = wid & 1;
    for (int unit = oblk(); unit < 64; unit += ogrid()) {
        const int nh = unit & 1, bh = unit >> 1, h = bh & 7, b = bh >> 3;
        for (int i = tid; i < 17408 / 4; i += NT) ((unsigned*)St)[i] = 0u;
        f32x4 sacc[2][2];
#pragma unroll
        for (int a = 0; a < 2; ++a)
#pragma unroll
            for (int c = 0; c < 2; ++c) sacc[a][c] = (f32x4){0.f, 0.f, 0.f, 0.f};
        __syncthreads();
        for (int n = 0; n < 64; ++n) {
            const size_t cu = (size_t)bh * 64 + n;
            bf16x8 sf[2][4];
#pragma unroll
            for (int j = 0; j < 2; ++j)
#pragma unroll
                for (int ks = 0; ks < 4; ++ks) sf[j][ks] = *(const bf16x8*)(St + (16 * (2 * nq + j) + fr) * 272 + (32 * ks + 8 * fq) * 2);
            f32x4 a1[2];
            {
                bf16x8 wf[4];
#pragma unroll
                for (int ks = 0; ks < 4; ++ks) wf[ks] = *(const bf16x8*)(Wn + (cu * 64 + 16 * cm + fr) * 128 + 32 * ks + 8 * fq);
#pragma unroll
                for (int j = 0; j < 2; ++j) {
                    const u32x2 uu = *(const u32x2*)(UT + (cu * 128 + nh * 64 + 16 * (2 * nq + j) + fr) * 64 + 16 * cm + 4 * fq);
                    a1[j] = (f32x4){bflo(uu[0]), bfhi(uu[0]), bflo(uu[1]), bfhi(uu[1])};
#pragma unroll
                    for (int ks = 0; ks < 4; ++ks) a1[j] = __builtin_amdgcn_mfma_f32_16x16x32_bf16(wf[ks], sf[j][ks], a1[j], 0, 0, 0);
                    u32x2 t; t[0] = pk2(a1[j][0], a1[j][1]); t[1] = pk2(a1[j][2], a1[j][3]);
                    *(u32x2*)(Vt + (16 * (2 * nq + j) + fr) * 144 + (16 * cm + 4 * fq) * 2) = t;
                }
            }
            __syncthreads();
            bf16x8 vf[2][2];
#pragma unroll
            for (int j = 0; j < 2; ++j)
#pragma unroll
                for (int k2 = 0; k2 < 2; ++k2) vf[j][k2] = *(const bf16x8*)(Vt + (16 * (2 * nq + j) + fr) * 144 + (32 * k2 + 8 * fq) * 2);
            {
                bf16x8 qf[4], af[2];
#pragma unroll
                for (int ks = 0; ks < 4; ++ks) qf[ks] = *(const bf16x8*)(Qd + (cu * 64 + 16 * cm + fr) * 128 + 32 * ks + 8 * fq);
#pragma unroll
                for (int k2 = 0; k2 < 2; ++k2) af[k2] = *(const bf16x8*)(At + (cu * 64 + 16 * cm + fr) * 64 + 32 * k2 + 8 * fq);
#pragma unroll
                for (int j = 0; j < 2; ++j) {
                    f32x4 a2 = (f32x4){0.f, 0.f, 0.f, 0.f};
#pragma unroll
                    for (int ks = 0; ks < 4; ++ks) a2 = __builtin_amdgcn_mfma_f32_16x16x32_bf16(sf[j][ks], qf[ks], a2, 0, 0, 0);
#pragma unroll
                    for (int k2 = 0; k2 < 2; ++k2) a2 = __builtin_amdgcn_mfma_f32_16x16x32_bf16(vf[j][k2], af[k2], a2, 0, 0, 0);
                    *(f32x4*)(O + (size_t)(b * SEQ + n * 64 + 16 * cm + fr) * DM + h * 128 + nh * 64 + 16 * (2 * nq + j) + 4 * fq) = a2;
                }
            }
            {
                const float eg = egl[cu];
#pragma unroll
                for (int d2 = 0; d2 < 2; ++d2) {
                    bf16x8 kf[2];
#pragma unroll
                    for (int k2 = 0; k2 < 2; ++k2) kf[k2] = *(const bf16x8*)(KdT + (cu * 128 + 16 * (2 * cm + d2) + fr) * 64 + 32 * k2 + 8 * fq);
#pragma unroll
                    for (int j = 0; j < 2; ++j) {
                        sacc[d2][j] = sacc[d2][j] * eg;
#pragma unroll
                        for (int k2 = 0; k2 < 2; ++k2) sacc[d2][j] = __builtin_amdgcn_mfma_f32_16x16x32_bf16(kf[k2], vf[j][k2], sacc[d2][j], 0, 0, 0);
                        u32x2 t; t[0] = pk2(sacc[d2][j][0], sacc[d2][j][1]); t[1] = pk2(sacc[d2][j][2], sacc[d2][j][3]);
                        *(u32x2*)(St + (16 * (2 * nq + j) + fr) * 272 + (16 * (2 * cm + d2) + 4 * fq) * 2) = t;
                    }
                }
            }
            __syncthreads();
        }
    }
}

#define LAS __attribute__((address_space(3)))
#define XB_TMO      128
#define XB_XCNT(j)  (256  + 64 * (j))
#define XB_XSUB(j)  (1280 + 64 * (j))
#define XB_XGEN(j)  (2304 + 64 * (j))
#define XB_TOP      3328
#define XB_TOPGEN   3392
#define XCD_BAR_WORDS 3456
#define XB_SPIN_CAP (1u << 18)
constexpr int CW_BAR = 4096;
__device__ __forceinline__ unsigned xb_ld(unsigned* p)              { return __hip_atomic_load(p, __ATOMIC_RELAXED, __HIP_MEMORY_SCOPE_AGENT); }
__device__ __forceinline__ unsigned xb_add(unsigned* p, unsigned v) { return __hip_atomic_fetch_add(p, v, __ATOMIC_RELAXED, __HIP_MEMORY_SCOPE_AGENT); }
__device__ __forceinline__ unsigned xb_xcc_id() { return (unsigned)__builtin_amdgcn_s_getreg((3 << 11) | 20) & 0xFu; }
#define XB_SPIN(cond, bar) do { unsigned _sp = 0; while (cond) { __builtin_amdgcn_s_sleep(1); \
    if ((++_sp & 255u) == 0u) { if (xb_ld(&(bar)[XB_TMO])) break; if (_sp > XB_SPIN_CAP) { atomicAdd(&(bar)[XB_TMO], 1u); break; } } } } while (0)
struct XcdBarrier { unsigned* bar; unsigned x; volatile LAS unsigned* st; };
__device__ __forceinline__ XcdBarrier xcd_barrier_post(unsigned* bar, volatile LAS unsigned* st) {
    XcdBarrier b; b.bar = bar; b.x = xb_xcc_id(); b.st = st;
    if (threadIdx.x == 0) (void)xb_add(&bar[XB_XCNT(b.x)], 1u);
    return b;
}
__device__ __forceinline__ void xcd_barrier_complete(unsigned* bar, unsigned x, unsigned& nloc, unsigned& nx) {
    const unsigned G = gridDim.x * gridDim.y * gridDim.z;
    unsigned sum, cnt, mine, sp = 0u;
    for (;;) {
        sum = 0u; cnt = 0u; mine = 0u;
#pragma unroll
        for (unsigned j = 0; j < 16; ++j) { const unsigned c = xb_ld(&bar[XB_XCNT(j)]); sum += c; cnt += (c > 0u) ? 1u : 0u; mine = (j == x) ? c : mine; }
        if (sum == G) break;
        __builtin_amdgcn_s_sleep(1);
        if ((++sp & 255u) == 0u) { if (xb_ld(&bar[XB_TMO])) break; if (sp > XB_SPIN_CAP) { atomicAdd(&bar[XB_TMO], 1u); break; } }
    }
    nloc = mine > 0u ? mine : 1u; nx = cnt > 0u ? cnt : 1u;
}
__device__ __forceinline__ void xcd_barrier(const XcdBarrier& b) {
    asm volatile("s_waitcnt vmcnt(0)" ::: "memory");
    __syncthreads();
    if (threadIdx.x == 0) {
        unsigned* bar = b.bar;
        __builtin_amdgcn_s_waitcnt(0);
        unsigned nloc = b.st[0], nx = b.st[1];
        if (nloc == 0u) { xcd_barrier_complete(bar, b.x, nloc, nx); b.st[0] = nloc; b.st[1] = nx; }
        const unsigned old = xb_add(&bar[XB_XSUB(b.x)], 1u);
        const unsigned gen = old / nloc;
        if (old + 1u == (gen + 1u) * nloc) {
            __builtin_amdgcn_fence(__ATOMIC_RELEASE, "agent");
            asm volatile("s_waitcnt vmcnt(0)" ::: "memory");
            const unsigned og = xb_add(&bar[XB_TOP], 1u);
            const unsigned tg = og / nx;
            if (og + 1u == (tg + 1u) * nx) xb_add(&bar[XB_TOPGEN], 1u);
            else XB_SPIN(xb_ld(&bar[XB_TOPGEN]) == tg, bar);
            __builtin_amdgcn_fence(__ATOMIC_ACQUIRE, "agent");
            xb_add(&bar[XB_XGEN(b.x)], 1u);
            asm volatile("s_waitcnt vmcnt(0)" ::: "memory");
        } else {
            XB_SPIN(xb_ld(&bar[XB_XGEN(b.x)]) == gen, bar);
            __builtin_amdgcn_fence(__ATOMIC_ACQUIRE, "agent");
            asm volatile("s_waitcnt vmcnt(0)" ::: "memory");
        }
    }
    __syncthreads();
}

__device__ __forceinline__ Params launder(const Params& p) {
    Params q = p;
    asm volatile("" : "+s"(q.x), "+s"(q.c), "+s"(q.ada_w), "+s"(q.ada_b), "+s"(q.norm_w), "+s"(q.conv_in_w), "+s"(q.conv_w), "+s"(q.conv_out_w), "+s"(q.gdn_in_w), "+s"(q.gdn_conv_w));
    asm volatile("" : "+s"(q.gdn_a_log), "+s"(q.gdn_dt_bias), "+s"(q.gdn_norm_w), "+s"(q.gdn_out_w), "+s"(q.moe_group_w), "+s"(q.moe_group_b), "+s"(q.moe_expert_w), "+s"(q.moe_expert_b));
    asm volatile("" : "+s"(q.moe_w_gate), "+s"(q.moe_w_up), "+s"(q.moe_w_down), "+s"(q.sh_w_gate), "+s"(q.sh_w_up), "+s"(q.sh_w_down), "+s"(q.sh_gate_w), "+s"(q.out), "+s"(q.ws));
    return q;
}
#define WS_BF(off) ((bf16_t*)(q.ws + (off)))
#define PH(n, ...) if (p.ph_lo <= (n) && (n) < p.ph_hi) { { const Params q = launder(p); __VA_ARGS__; } if ((n) + 1 < p.ph_hi) xcd_barrier(bar); }
__global__ void __launch_bounds__(NT) mega_fwd(Params p) {
    __shared__ __attribute__((aligned(16))) unsigned char lds[LDS_BYTES];
    volatile LAS unsigned* bst = (volatile LAS unsigned*)(LAS unsigned char*)(lds + LDS_BYTES - 16);
    if (threadIdx.x < 4) bst[threadIdx.x] = 0u;
    __syncthreads();
    const XcdBarrier bar = xcd_barrier_post((unsigned*)(p.ws + WS_CTL) + CW_BAR, bst);
    PH(0, phase_prologue(q, lds))
    PH(1, phase_h0(q))
    PH(2, phase_gemm_convin(q, lds))
    PH(3, phase_conv(q))
    PH(4, phase_gemm_plain(q, lds, WS_BF(WS_HA), WS_BF(WS_W_CONVOUT), 4, 1024, WS_BF(R_YO), 1024, 0))
    PH(5, phase_post_mixer(q, lds, 0))
    PH(6, phase_moe_gu(q, lds, 0))
    PH(7, phase_moe_down(q, lds, 0))
    PH(8, phase_post_moe(q, lds, 0, false))
    PH(9, phase_gemm_plain(q, lds, WS_BF(WS_HA), WS_BF(WS_W_GDNIN), 16, 1024, WS_BF(R_PLANES), 1024, 1))
    PH(10, phase_gdn_prep(q, lds))
    PH(11, phase_gdn_scan(q, lds))
    PH(12, phase_gdn_gate(q))
    PH(13, phase_gemm_plain(q, lds, WS_BF(WS_HA), WS_BF(WS_W_GDNOUT), 4, 1024, WS_BF(R_YO), 1024, 0))
    PH(14, phase_post_mixer(q, lds, 1))
    PH(15, phase_moe_gu(q, lds, 1))
    PH(16, phase_moe_down(q, lds, 1))
    PH(17, phase_post_moe(q, lds, 1, true))
}

extern "C" void kernel_launch(void* const* d_in, const int* in_sizes, int n_in, void* d_out, int out_size, void* d_ws, size_t ws_size, hipStream_t stream) {
    static int grid_blocks = 0;
    if (!grid_blocks) {
        int dev = 0, cus = 0, per_cu = 0;
        hipGetDevice(&dev);
        hipDeviceGetAttribute(&cus, hipDeviceAttributeMultiprocessorCount, dev);
        hipOccupancyMaxActiveBlocksPerMultiprocessor(&per_cu, mega_fwd, NT, 0);
        if (per_cu < 1) { fprintf(stderr, "kernel_launch: occupancy query says %d blocks per CU\n", per_cu); per_cu = 1; }
        grid_blocks = cus;
        if (ws_size < WS_END) fprintf(stderr, "kernel_launch: workspace too small: %zu < %zu\n", ws_size, (size_t)WS_END);
    }
    Params p{};
    const float** f = (const float**)&p;
    for (int i = 0; i < 25; ++i) f[i] = (const float*)d_in[i];
    p.out = (float*)d_out; p.ws = (unsigned char*)d_ws;
    hipMemsetAsync((char*)d_ws + WS_CTL, 0, 65536, stream);
#if N_LAUNCH_MODE
    for (int ph = 0; ph < NPHASE; ++ph) {
        p.ph_lo = ph; p.ph_hi = ph + 1;
        hipLaunchKernelGGL(mega_fwd, dim3(grid_blocks), dim3(NT), 0, stream, p);
    }
#else
    p.ph_lo = 0; p.ph_hi = NPHASE;
    void* args[] = {&p};
    hipError_t e = hipLaunchCooperativeKernel((void*)mega_fwd, dim3(grid_blocks), dim3(NT), args, 0, stream);
    if (e != hipSuccess) fprintf(stderr, "cooperative launch failed: %s (grid %d)\n", hipGetErrorString(e), grid_blocks);
#endif
}
```

```cpp
#include <hip/hip_runtime.h>
#include <hip/hip_cooperative_groups.h>
#include <cstdio>
#include <cstdint>
namespace cg = cooperative_groups;

typedef unsigned short bf16_t;
typedef short bf16x8 __attribute__((ext_vector_type(8)));
typedef float f32x4 __attribute__((ext_vector_type(4)));
typedef unsigned u32x4 __attribute__((ext_vector_type(4)));
typedef unsigned u32x2 __attribute__((ext_vector_type(2)));
#define LAS __attribute__((address_space(3)))

#ifndef N_LAUNCH_MODE
#define N_LAUNCH_MODE 0
#endif

constexpr int NT = 512;
constexpr int NTOK = 16384, DM = 1024, SEQ = 4096;
constexpr float EPS = 1e-6f;
constexpr int LDS_BYTES = 163840;
constexpr int NPHASE = 18;

constexpr size_t MiB = 1048576;
constexpr size_t WS_CTL    = 0;
constexpr size_t WS_MOD    = 65536;
constexpr size_t WS_GATES  = WS_MOD + 196608;
constexpr size_t WS_SG     = WS_GATES + 131072;
constexpr size_t WS_EGL    = WS_SG + 65536;
constexpr size_t WS_BA     = 1 * MiB;
constexpr size_t WS_LIST   = 2 * MiB;
constexpr size_t WS_W_CONVIN  = 6 * MiB;
constexpr size_t WS_W_CONVOUT = 12 * MiB;
constexpr size_t WS_W_GDNIN   = 14 * MiB;
constexpr size_t WS_W_GDNOUT  = 22 * MiB;
constexpr size_t WS_W_SHGU    = 24 * MiB;
constexpr size_t WS_W_SHD     = 28 * MiB;
constexpr size_t WS_W_MOEGU   = 30 * MiB;
constexpr size_t WS_W_MOED    = 94 * MiB;
constexpr size_t WS_HA        = 126 * MiB;
constexpr size_t WS_R         = 158 * MiB;
constexpr size_t R_PLANES = WS_R;
constexpr size_t R_O      = WS_R;
constexpr size_t R_WN     = WS_R + 128 * MiB;
constexpr size_t R_QD     = WS_R + 160 * MiB;
constexpr size_t R_KDT    = WS_R + 192 * MiB;
constexpr size_t R_UT     = WS_R + 224 * MiB;
constexpr size_t R_AT     = WS_R + 256 * MiB;
constexpr size_t R_YO     = WS_R + 128 * MiB;
constexpr size_t R_B      = WS_R;
constexpr size_t R_U      = WS_R + 32 * MiB;
constexpr size_t R_HIDR   = WS_R;
constexpr size_t R_HIDS   = WS_R + 32 * MiB;
constexpr size_t R_YBUF   = WS_R + 160 * MiB;
constexpr size_t WS_END   = WS_R + 272 * MiB;

struct Params {
    const float* x; const float* c; const float* ada_w; const float* ada_b; const float* norm_w;
    const float* conv_in_w; const float* conv_w; const float* conv_out_w;
    const float* gdn_in_w; const float* gdn_conv_w; const float* gdn_a_log; const float* gdn_dt_bias; const float* gdn_norm_w; const float* gdn_out_w;
    const float* moe_group_w; const float* moe_group_b; const float* moe_expert_w; const float* moe_expert_b;
    const float* moe_w_gate; const float* moe_w_up; const float* moe_w_down;
    const float* sh_w_gate; const float* sh_w_up; const float* sh_w_down; const float* sh_gate_w;
    float* out; unsigned char* ws; int ph_lo, ph_hi;
};

__device__ __forceinline__ int otid() { int t = threadIdx.x; asm volatile("" : "+v"(t)); return t; }
__device__ __forceinline__ int oblk() { int t = blockIdx.x; asm volatile("" : "+s"(t)); return t; }
__device__ __forceinline__ int ogrid() { int t = gridDim.x; asm volatile("" : "+s"(t)); return t; }
__device__ __forceinline__ unsigned f2bf(float f) { unsigned u = __float_as_uint(f); return (u + 0x7fffu + ((u >> 16) & 1u)) >> 16; }
__device__ __forceinline__ unsigned pk2(float lo, float hi) { return f2bf(lo) | (f2bf(hi) << 16); }
__device__ __forceinline__ float bflo(unsigned w) { return __uint_as_float(w << 16); }
__device__ __forceinline__ float bfhi(unsigned w) { return __uint_as_float(w & 0xffff0000u); }
__device__ __forceinline__ float wave_sum(float v) {
#pragma unroll
    for (int o = 32; o; o >>= 1) v += __shfl_xor(v, o);
    return v;
}
__device__ __forceinline__ float siluf(float x) { return x / (1.f + __expf(-x)); }
__device__ __forceinline__ float sigmf(float x) { return 1.f / (1.f + __expf(-x)); }

__device__ __forceinline__ void ld_row_f32(const float* row, int lane, float (&v)[16]) {
#pragma unroll
    for (int j = 0; j < 4; ++j) { const f32x4 t = *(const f32x4*)(row + 256 * j + 4 * lane); v[4 * j] = t[0]; v[4 * j + 1] = t[1]; v[4 * j + 2] = t[2]; v[4 * j + 3] = t[3]; }
}
__device__ __forceinline__ void ld_row_bf16(const bf16_t* row, int lane, float (&v)[16]) {
#pragma unroll
    for (int j = 0; j < 4; ++j) { const u32x2 t = *(const u32x2*)(row + 256 * j + 4 * lane); v[4 * j] = bflo(t[0]); v[4 * j + 1] = bfhi(t[0]); v[4 * j + 2] = bflo(t[1]); v[4 * j + 3] = bfhi(t[1]); }
}
__device__ __forceinline__ void st_row_f32(float* row, int lane, const float (&v)[16]) {
#pragma unroll
    for (int j = 0; j < 4; ++j) { f32x4 t; t[0] = v[4 * j]; t[1] = v[4 * j + 1]; t[2] = v[4 * j + 2]; t[3] = v[4 * j + 3]; *(f32x4*)(row + 256 * j + 4 * lane) = t; }
}
__device__ __forceinline__ void st_row_bf16(bf16_t* row, int lane, const float (&v)[16]) {
#pragma unroll
    for (int j = 0; j < 4; ++j) { u32x2 t; t[0] = pk2(v[4 * j], v[4 * j + 1]); t[1] = pk2(v[4 * j + 2], v[4 * j + 3]); *(u32x2*)(row + 256 * j + 4 * lane) = t; }
}
__device__ __forceinline__ float sumsq16(const float (&v)[16]) {
    float s = 0.f;
#pragma unroll
    for (int i = 0; i < 16; ++i) s += v[i] * v[i];
    return s;
}

struct TJob { const float* s0; const float* s1; bf16_t* dst; int K, Nd, ld, type, tpg, ngroups; long sstride, dstride; };
__device__ __forceinline__ const float* tjob_src(const TJob& j, const float* s0, const float* s1, int r) {
    if (j.type == 0) return s0 + r;
    if (j.type == 1) { if (r < 1024) return s0 + r; const int rr = r - 1024, blk = rr >> 5, hi = (rr >> 4) & 1; return s0 + 1024 + hi * 1024 + 16 * blk + (rr & 15); }
    const int blk = r >> 5, hi = (r >> 4) & 1; return (hi ? s1 : s0) + 16 * blk + (r & 15);
}
__device__ __forceinline__ void transpose_tile(float* tl, const TJob& j, int tile) {
    const int tid = otid();
    const int g = tile / j.tpg, tt = tile % j.tpg;
    const int nkt = j.K >> 8;
    const int r0 = (tt / nkt) * 64, k0 = (tt % nkt) * 256;
    const float* s0 = j.s0 + (long)g * j.sstride; const float* s1 = j.s1 ? j.s1 + (long)g * j.sstride : nullptr;
    bf16_t* dst = j.dst + (long)g * j.dstride;
    {
        const int rq = tid & 15, kk = tid >> 4;
        const float* sp = tjob_src(j, s0, s1, r0 + 4 * rq) + (long)(k0 + kk) * j.ld;
        f32x4 v[8];
#pragma unroll
        for (int i = 0; i < 8; ++i) v[i] = *(const f32x4*)(sp + (long)(32 * i) * j.ld);
#pragma unroll
        for (int i = 0; i < 8; ++i) {
            float* q = tl + (4 * rq) * 257 + kk + 32 * i;
            q[0] = v[i][0]; q[257] = v[i][1]; q[514] = v[i][2]; q[771] = v[i][3];
        }
    }
    __syncthreads();
    {
        const int r = tid >> 3, a = tid & 7;
#pragma unroll
        for (int i = 0; i < 4; ++i) {
            const float* q = tl + r * 257 + 64 * i + 8 * a;
            u32x4 w; w[0] = pk2(q[0], q[1]); w[1] = pk2(q[2], q[3]); w[2] = pk2(q[4], q[5]); w[3] = pk2(q[6], q[7]);
            *(u32x4*)(dst + (long)(r0 + r) * j.K + k0 + 64 * i + 8 * a) = w;
        }
    }
    __syncthreads();
}
__device__ __forceinline__ void tjob_set(TJob* j, const float* s0, const float* s1, bf16_t* dst, int K, int Nd, int ld, int type, int ngroups, long sstride, long dstride) {
    j->s0 = s0; j->s1 = s1; j->dst = dst; j->K = K; j->Nd = Nd; j->ld = ld; j->type = type; j->tpg = (Nd >> 6) * (K >> 8); j->ngroups = ngroups; j->sstride = sstride; j->dstride = dstride;
}
__device__ __forceinline__ void run_tjobs(unsigned char* lds, int nj, int brel, int nb) {
    TJob* jobs = (TJob*)lds; float* tl = (float*)(lds + 4096);
    int base = 0;
    for (int q = 0; q < nj; ++q) {
        const TJob j = jobs[q];
        const int nt = j.tpg * j.ngroups;
        int first = (brel - base % nb + nb) % nb;
        for (int t = first; t < nt; t += nb) transpose_tile(tl, j, t);
        base += nt;
    }
}
__device__ __forceinline__ void moe_weight_jobs(const Params& p, int layer, TJob* jobs) {
    bf16_t* wgu = (bf16_t*)(p.ws + WS_W_MOEGU); bf16_t* wd = (bf16_t*)(p.ws + WS_W_MOED);
    const long lo = (long)layer * 64 * 1024 * 256;
    tjob_set(jobs + 0, p.moe_w_gate + lo, p.moe_w_up + lo, wgu, 1024, 512, 256, 2, 64, 1024L * 256, 512L * 1024);
    tjob_set(jobs + 1, p.moe_w_down + lo, nullptr, wd, 256, 1024, 1024, 0, 64, 256L * 1024, 1024L * 256);
}

__device__ __forceinline__ void phase_prologue(const Params& p, unsigned char* lds) {
    const int tid = otid();
    for (int u = oblk(); u < 192; u += ogrid()) {
        float* cs = (float*)lds; float* red = (float*)(lds + 16384);
        for (int i = tid; i < 4096; i += NT) cs[i] = siluf(p.c[i]);
        __syncthreads();
        const int l = u / 96, cgp = u % 96, col = tid & 63, kg = tid >> 6;
        const float* w = p.ada_w + (size_t)l * 1024 * 6144 + cgp * 64 + col;
        float a0 = 0.f, a1 = 0.f, a2 = 0.f, a3 = 0.f;
#pragma unroll 8
        for (int k = kg; k < 1024; k += 8) { const float wv = w[(size_t)k * 6144]; a0 += cs[k] * wv; a1 += cs[1024 + k] * wv; a2 += cs[2048 + k] * wv; a3 += cs[3072 + k] * wv; }
        red[(kg * 4 + 0) * 64 + col] = a0; red[(kg * 4 + 1) * 64 + col] = a1; red[(kg * 4 + 2) * 64 + col] = a2; red[(kg * 4 + 3) * 64 + col] = a3;
        __syncthreads();
        if (tid < 256) {
            const int b = tid >> 6; float s = 0.f;
#pragma unroll
            for (int g = 0; g < 8; ++g) s += red[(g * 4 + b) * 64 + col];
            float* mod = (float*)(p.ws + WS_MOD);
            mod[(l * 4 + b) * 6144 + cgp * 64 + col] = s + p.ada_b[l * 6144 + cgp * 64 + col];
        }
        __syncthreads();
    }
    TJob* jobs = (TJob*)lds;
    if (tid == 0) {
        unsigned char* ws = p.ws;
        tjob_set(jobs + 0, p.conv_in_w, nullptr, (bf16_t*)(ws + WS_W_CONVIN), 1024, 3072, 3072, 1, 1, 0, 0);
        tjob_set(jobs + 1, p.conv_out_w, nullptr, (bf16_t*)(ws + WS_W_CONVOUT), 1024, 1024, 1024, 0, 1, 0, 0);
        tjob_set(jobs + 2, p.gdn_in_w, nullptr, (bf16_t*)(ws + WS_W_GDNIN), 1024, 4096, 4112, 0, 1, 0, 0);
        tjob_set(jobs + 3, p.gdn_out_w, nullptr, (bf16_t*)(ws + WS_W_GDNOUT), 1024, 1024, 1024, 0, 1, 0, 0);
        tjob_set(jobs + 4, p.sh_w_gate, p.sh_w_up, (bf16_t*)(ws + WS_W_SHGU), 1024, 1024, 512, 2, 2, 1024L * 512, 1024L * 1024);
        tjob_set(jobs + 5, p.sh_w_down, nullptr, (bf16_t*)(ws + WS_W_SHD), 512, 1024, 1024, 0, 2, 512L * 1024, 1024L * 512);
        moe_weight_jobs(p, 0, jobs + 6);
    }
    __syncthreads();
    run_tjobs(lds, 8, oblk(), ogrid());
}

struct ColP { float v[16]; };
__device__ __forceinline__ void ld_colp(const float* base, int lane, ColP& c) { ld_row_f32(base, lane, c.v); }
__device__ __forceinline__ const float* modp(const Params& p, int l, int b, int chunk) { return (const float*)(p.ws + WS_MOD) + (l * 4 + b) * 6144 + chunk * 1024; }

__device__ __forceinline__ void phase_h0(const Params& p) {
    const int lane = otid() & 63, wid = otid() >> 6;
    bf16_t* hA = (bf16_t*)(p.ws + WS_HA);
    ColP nw; ld_colp(p.norm_w + 0, lane, nw);
    for (int tok = oblk() * 8 + wid; tok < NTOK; tok += ogrid() * 8) {
        const int b = tok >> 12;
        float v[16]; ld_row_f32(p.x + (size_t)tok * DM, lane, v);
        const float r = rsqrtf(wave_sum(sumsq16(v)) * (1.f / DM) + EPS);
        ColP sc, sh; ld_colp(modp(p, 0, b, 1), lane, sc); ld_colp(modp(p, 0, b, 0), lane, sh);
#pragma unroll
        for (int i = 0; i < 16; ++i) v[i] = v[i] * r * nw.v[i] * (1.f + sc.v[i]) + sh.v[i];
        st_row_bf16(hA + (size_t)tok * DM, lane, v);
    }
}

__device__ __forceinline__ void phase_conv(const Params& p) {
    const int lane = otid() & 63, wid = otid() >> 6;
    const bf16_t* Bb = (const bf16_t*)(p.ws + R_B); const bf16_t* Ub = (const bf16_t*)(p.ws + R_U);
    bf16_t* hA = (bf16_t*)(p.ws + WS_HA);
    ColP w0, w1, w2; ld_colp(p.conv_w, lane, w0); ld_colp(p.conv_w + 1024, lane, w1); ld_colp(p.conv_w + 2048, lane, w2);
    for (int tok = oblk() * 8 + wid; tok < NTOK; tok += ogrid() * 8) {
        const int t = tok & (SEQ - 1);
        float bb[16], u0[16], u1[16], u2[16];
        ld_row_bf16(Bb + (size_t)tok * DM, lane, bb);
        ld_row_bf16(Ub + (size_t)tok * DM, lane, u2);
        if (t >= 1) ld_row_bf16(Ub + (size_t)(tok - 1) * DM, lane, u1); else {
#pragma unroll
            for (int i = 0; i < 16; ++i) u1[i] = 0.f; }
        if (t >= 2) ld_row_bf16(Ub + (size_t)(tok - 2) * DM, lane, u0); else {
#pragma unroll
            for (int i = 0; i < 16; ++i) u0[i] = 0.f; }
        float y[16];
#pragma unroll
        for (int i = 0; i < 16; ++i) y[i] = bb[i] * (w0.v[i] * u0[i] + w1.v[i] * u1[i] + w2.v[i] * u2[i]);
        st_row_bf16(hA + (size_t)tok * DM, lane, y);
    }
}

template <int NCT, class BF>
__device__ __forceinline__ void smalln_gemm(const float* Hs, float* Ps, int wid, int lane, const BF& bf) {
    f32x4 acc[NCT];
#pragma unroll
    for (int c = 0; c < NCT; ++c) acc[c] = (f32x4){0.f, 0.f, 0.f, 0.f};
    const int row = lane & 15, kq = lane >> 4;
    const float* hrow = Hs + row * 1026 + 128 * wid + kq;
#pragma unroll 4
    for (int s = 0; s < 32; ++s) {
        const float a = hrow[4 * s];
        const int k = 128 * wid + 4 * s + kq;
#pragma unroll
        for (int c = 0; c < NCT; ++c) acc[c] = __builtin_amdgcn_mfma_f32_16x16x4f32(a, bf(k, c, row), acc[c], 0, 0, 0);
    }
#pragma unroll
    for (int c = 0; c < NCT; ++c)
#pragma unroll
        for (int r = 0; r < 4; ++r) Ps[(wid * 16 + 4 * kq + r) * (NCT * 16) + c * 16 + row] = acc[c][r];
}

struct RouteB {
    const float* we; const float* wg; const float* wsg;
    __device__ __forceinline__ float operator()(int k, int ct, int c16) const {
        if (ct < 4) return we[k * 64 + ct * 16 + c16];
        if (c16 < 8) return wg[k * 8 + c16];
        if (c16 == 8) return wsg[k];
        return 0.f;
    }
};
struct BaB { const float* w; __device__ __forceinline__ float operator()(int k, int, int c16) const { return w[(size_t)k * 4112 + 4096 + c16]; } };

__device__ __forceinline__ void phase_post_mixer(const Params& p, unsigned char* lds, int l) {
    const int tid = otid(), lane = tid & 63, wid = tid >> 6;
    float* Hs = (float*)lds;
    float* Ps = (float*)(lds + 65792);
    float* Lg = (float*)(lds + 65792 + 40960);
    const float* xin = (l == 0) ? p.x : p.out;
    const bf16_t* yo = (const bf16_t*)(p.ws + R_YO);
    bf16_t* hA = (bf16_t*)(p.ws + WS_HA);
    int* cnt = (int*)(p.ws + WS_CTL) + l * 64;
    int* list = (int*)(p.ws + WS_LIST);
    float* gates = (float*)(p.ws + WS_GATES); float* sgt = (float*)(p.ws + WS_SG);
    ColP nw1, nw2; ld_colp(p.norm_w + (l * 4 + 1) * 1024, lane, nw1); ld_colp(p.norm_w + (l * 4 + 2) * 1024, lane, nw2);
    RouteB rb; rb.we = p.moe_expert_w + (size_t)l * 1024 * 64; rb.wg = p.moe_group_w + (size_t)l * 1024 * 8; rb.wsg = p.sh_gate_w + (size_t)l * 1024;
    for (int g16 = oblk(); g16 < NTOK / 16; g16 += ogrid()) {
#pragma unroll 1
        for (int q = 0; q < 2; ++q) {
            const int tl = wid * 2 + q, tok = g16 * 16 + tl, b = tok >> 12;
            float xv[16], yv[16];
            ld_row_f32(xin + (size_t)tok * DM, lane, xv); ld_row_bf16(yo + (size_t)tok * DM, lane, yv);
            const float r1 = rsqrtf(wave_sum(sumsq16(yv)) * (1.f / DM) + EPS);
            ColP gt; ld_colp(modp(p, l, b, 2), lane, gt);
#pragma unroll
            for (int i = 0; i < 16; ++i) xv[i] = xv[i] + gt.v[i] * (yv[i] * r1 * nw1.v[i]);
            st_row_f32(p.out + (size_t)tok * DM, lane, xv);
            const float r2 = rsqrtf(wave_sum(sumsq16(xv)) * (1.f / DM) + EPS);
            ColP sc, sh; ld_colp(modp(p, l, b, 4), lane, sc); ld_colp(modp(p, l, b, 3), lane, sh);
#pragma unroll
            for (int i = 0; i < 16; ++i) xv[i] = xv[i] * r2 * nw2.v[i] * (1.f + sc.v[i]) + sh.v[i];
            st_row_bf16(hA + (size_t)tok * DM, lane, xv);
#pragma unroll
            for (int j = 0; j < 4; ++j)
#pragma unroll
                for (int i = 0; i < 4; ++i) Hs[tl * 1026 + 256 * j + 4 * lane + i] = xv[4 * j + i];
        }
        __syncthreads();
        smalln_gemm<5>(Hs, Ps, wid, lane, rb);
        __syncthreads();
        for (int i = tid; i < 16 * 80; i += NT) { float s = 0.f;
#pragma unroll
            for (int w = 0; w < 8; ++w) s += Ps[w * 1280 + i];
            Lg[i] = s; }
        __syncthreads();
        if (tid < 16) {
            const int tok = g16 * 16 + tid; const float* lg = Lg + tid * 80;
            float gl[8]; float gm = -3.4e38f; int gs = 0;
#pragma unroll
            for (int g = 0; g < 8; ++g) { gl[g] = lg[64 + g] + p.moe_group_b[l * 8 + g]; if (gl[g] > gm) { gm = gl[g]; gs = g; } }
            float den = 0.f;
#pragma unroll
            for (int g = 0; g < 8; ++g) den += __expf(gl[g] - gm);
            const float psel = 1.f / den;
            float el[8];
#pragma unroll
            for (int j = 0; j < 8; ++j) el[j] = lg[gs * 8 + j] + p.moe_expert_b[l * 64 + gs * 8 + j];
            float v1 = -3.4e38f; int i1 = 0;
#pragma unroll
            for (int j = 0; j < 8; ++j) if (el[j] > v1) { v1 = el[j]; i1 = j; }
            float v2 = -3.4e38f; int i2 = 0;
#pragma unroll
            for (int j = 0; j < 8; ++j) if (j != i1 && el[j] > v2) { v2 = el[j]; i2 = j; }
            const float e2 = __expf(v2 - v1);
            const float g1 = psel / (1.f + e2), g2 = psel * e2 / (1.f + e2);
            const int e1id = gs * 8 + i1, e2id = gs * 8 + i2;
            gates[tok * 2] = g1; gates[tok * 2 + 1] = g2; sgt[tok] = sigmf(lg[72]);
            const int p1 = atomicAdd(&cnt[e1id], 1); list[e1id * NTOK + p1] = tok * 2;
            const int p2 = atomicAdd(&cnt[e2id], 1); list[e2id * NTOK + p2] = tok * 2 + 1;
        }
        __syncthreads();
    }
}

__device__ __forceinline__ void phase_post_moe(const Params& p, unsigned char* lds, int l, bool final) {
    const int tid = otid(), lane = tid & 63, wid = tid >> 6;
    float* Hs = (float*)lds; float* Ps = (float*)(lds + 65792);
    const bf16_t* yb = (const bf16_t*)(p.ws + R_YBUF);
    bf16_t* hA = (bf16_t*)(p.ws + WS_HA);
    float* ba = (float*)(p.ws + WS_BA);
    ColP nw3, nwn; ld_colp(p.norm_w + (l * 4 + 3) * 1024, lane, nw3);
    if (!final) ld_colp(p.norm_w + ((l + 1) * 4 + 0) * 1024, lane, nwn);
    BaB bb; bb.w = p.gdn_in_w;
    for (int g16 = oblk(); g16 < NTOK / 16; g16 += ogrid()) {
#pragma unroll 1
        for (int q = 0; q < 2; ++q) {
            const int tl = wid * 2 + q, tok = g16 * 16 + tl, b = tok >> 12;
            float xv[16], yv[16], t1[16];
            ld_row_f32(p.out + (size_t)tok * DM, lane, xv);
            ld_row_bf16(yb + (size_t)tok * DM, lane, yv);
            ld_row_bf16(yb + (size_t)(NTOK + tok) * DM, lane, t1);
#pragma unroll
            for (int i = 0; i < 16; ++i) yv[i] += t1[i];
            ld_row_bf16(yb + (size_t)(2 * NTOK + tok) * DM, lane, t1);
#pragma unroll
            for (int i = 0; i < 16; ++i) yv[i] += t1[i];
            const float r1 = rsqrtf(wave_sum(sumsq16(yv)) * (1.f / DM) + EPS);
            ColP gt; ld_colp(modp(p, l, b, 5), lane, gt);
#pragma unroll
            for (int i = 0; i < 16; ++i) xv[i] = xv[i] + gt.v[i] * (yv[i] * r1 * nw3.v[i]);
            st_row_f32(p.out + (size_t)tok * DM, lane, xv);
            if (!final) {
                const float r2 = rsqrtf(wave_sum(sumsq16(xv)) * (1.f / DM) + EPS);
                ColP sc, sh; ld_colp(modp(p, l + 1, b, 1), lane, sc); ld_colp(modp(p, l + 1, b, 0), lane, sh);
#pragma unroll
                for (int i = 0; i < 16; ++i) xv[i] = xv[i] * r2 * nwn.v[i] * (1.f + sc.v[i]) + sh.v[i];
                st_row_bf16(hA + (size_t)tok * DM, lane, xv);
#pragma unroll
                for (int j = 0; j < 4; ++j)
#pragma unroll
                    for (int i = 0; i < 4; ++i) Hs[tl * 1026 + 256 * j + 4 * lane + i] = xv[4 * j + i];
            }
        }
        if (!final) {
            __syncthreads();
            smalln_gemm<1>(Hs, Ps, wid, lane, bb);
            __syncthreads();
            if (tid < 256) { float s = 0.f;
#pragma unroll
                for (int w = 0; w < 8; ++w) s += Ps[w * 256 + tid];
                ba[(size_t)(g16 * 16) * 16 + tid] = s; }
            __syncthreads();
        }
    }
}

__device__ __forceinline__ void phase_gdn_gate(const Params& p) {
    const int lane = otid() & 63, wid = otid() >> 6;
    const float* o = (const float*)(p.ws + R_O);
    const bf16_t* z = (const bf16_t*)(p.ws + R_PLANES) + (size_t)3 * NTOK * DM;
    bf16_t* hA = (bf16_t*)(p.ws + WS_HA);
    float gw[16];
#pragma unroll
    for (int j = 0; j < 4; ++j)
#pragma unroll
        for (int i = 0; i < 4; ++i) gw[4 * j + i] = p.gdn_norm_w[(4 * lane + i) & 127];
    for (int tok = oblk() * 8 + wid; tok < NTOK; tok += ogrid() * 8) {
        float ov[16], zv[16];
        ld_row_f32(o + (size_t)tok * DM, lane, ov); ld_row_bf16(z + (size_t)tok * DM, lane, zv);
#pragma unroll
        for (int j = 0; j < 4; ++j) {
            float s = ov[4 * j] * ov[4 * j] + ov[4 * j + 1] * ov[4 * j + 1] + ov[4 * j + 2] * ov[4 * j + 2] + ov[4 * j + 3] * ov[4 * j + 3];
#pragma unroll
            for (int of = 16; of; of >>= 1) s += __shfl_xor(s, of);
            const float r = rsqrtf(s * (1.f / 128.f) + EPS);
#pragma unroll
            for (int i = 0; i < 4; ++i) ov[4 * j + i] = ov[4 * j + i] * r * gw[4 * j + i] * siluf(zv[4 * j + i]);
        }
        st_row_bf16(hA + (size_t)tok * DM, lane, ov);
    }
}

namespace pg8 {
constexpr int BK = 64, HALF = 128, HTB = HALF * BK * 2;
__device__ __forceinline__ int lds_byte(int r, int c) { const int st = (r >> 4) * 2 + (c >> 5), rr = r & 15, cc = c & 31, ob = rr * 64 + cc * 2; return st * 1024 + (ob ^ (((ob >> 9) & 1) << 5)); }
__device__ __forceinline__ void stage_rc(int b, int& R, int& C) { const int st = b / 1024, sb = b % 1024, swz = sb ^ (((sb >> 9) & 1) << 5); R = (st >> 1) * 16 + swz / 64; C = (st & 1) * 32 + (swz % 64) / 2; }
}
struct GUnit { const bf16_t* A; const int* gidx; const bf16_t* Bt; const int* lst; int gvalid, K, type, pm, pn, aux; };

template <class Sched, class Epi>
__device__ __forceinline__ void gemm_stream(unsigned char* lds_generic, const Sched& S, const Epi& E) {
    using namespace pg8;
    LAS unsigned char* lds = (LAS unsigned char*)lds_generic;
    const int tid = otid(), wid = __builtin_amdgcn_readfirstlane(tid >> 6), lane = tid & 63, wr = wid >> 2, wc = wid & 3, fr = lane & 15, fq = lane >> 4;
    int R0, C0, R1, C1; stage_rc(tid * 16, R0, C0); stage_rc(tid * 16 + 8192, R1, C1);
    const unsigned ldsw = (unsigned)wid * 1024u;
    const int aoff = lds_byte(wr * 64 + fr, fq * 8), boff = lds_byte(wc * 32 + fr, fq * 8);
#define PG8_SA(b, h) (((b) * 2 + (h)) * HTB)
#define PG8_SB(b, h) ((4 + (b) * 2 + (h)) * HTB)
#define PG8_ST2(bufoff, gbase, o0, o1) do { \
        __builtin_amdgcn_global_load_lds((const unsigned*)((const char*)(gbase) + (o0)), (LAS unsigned*)(lds + (bufoff) + ldsw), 16, 0, 0); \
        __builtin_amdgcn_global_load_lds((const unsigned*)((const char*)(gbase) + (o1)), (LAS unsigned*)(lds + (bufoff) + ldsw + 8192), 16, 0, 0); } while (0)
#define PG8_LDA(dst, b, h) do { _Pragma("unroll") for (int m = 0; m < 4; ++m) _Pragma("unroll") for (int k = 0; k < 2; ++k) dst[m][k] = *(const LAS bf16x8*)(lds + PG8_SA(b, h) + aoff + m * 2048 + k * 1024); } while (0)
#define PG8_LDB(dst, b, h) do { _Pragma("unroll") for (int n = 0; n < 2; ++n) _Pragma("unroll") for (int k = 0; k < 2; ++k) dst[n][k] = *(const LAS bf16x8*)(lds + PG8_SB(b, h) + boff + n * 2048 + k * 1024); } while (0)
#define PG8_MMA(ai, bj, At, Bt) do { __builtin_amdgcn_s_setprio(1); _Pragma("unroll") for (int m = 0; m < 4; ++m) _Pragma("unroll") for (int n = 0; n < 2; ++n) _Pragma("unroll") for (int k = 0; k < 2; ++k) \
        acc[ai][bj][m][n] = __builtin_amdgcn_mfma_f32_16x16x32_bf16(Bt[n][k], At[m][k], acc[ai][bj][m][n], 0, 0, 0); __builtin_amdgcn_s_setprio(0); } while (0)
#define PG8_WAIT_V(n) asm volatile("s_waitcnt vmcnt(" #n ")" ::: "memory")
#define PG8_WAIT_L(n) asm volatile("s_waitcnt lgkmcnt(" #n ")" ::: "memory")
#define PG8_BAR __builtin_amdgcn_s_barrier()
#define PG8_SCHED __builtin_amdgcn_sched_barrier(0)
#define PG8_SETUP(u, xa00, xa01, xa10, xa11) do { \
        int r00 = R0, r01 = R1, r10 = R0 + 128, r11 = R1 + 128; \
        if ((u).gidx) { const int gv = (u).gvalid; const int* gi = (u).gidx; \
            r00 = gi[R0 < gv ? R0 : 0] >> 1; r01 = gi[R1 < gv ? R1 : 0] >> 1; r10 = gi[R0 + 128 < gv ? R0 + 128 : 0] >> 1; r11 = gi[R1 + 128 < gv ? R1 + 128 : 0] >> 1; } \
        xa00 = (unsigned)(r00 * (u).K + C0) * 2u; xa01 = (unsigned)(r01 * (u).K + C1) * 2u; xa10 = (unsigned)(r10 * (u).K + C0) * 2u; xa11 = (unsigned)(r11 * (u).K + C1) * 2u; } while (0)
#define PG8_BOFF(K_, xb0, xb1) const unsigned xb0 = (unsigned)(R0 * (K_) + C0) * 2u, xb1 = (unsigned)(R1 * (K_) + C1) * 2u
    GUnit cur, nxt; int ui = 0;
    if (!S.next(0, cur)) return;
    f32x4 acc[2][2][4][2];
#pragma unroll
    for (int a = 0; a < 2; ++a)
#pragma unroll
        for (int b = 0; b < 2; ++b)
#pragma unroll
            for (int m = 0; m < 4; ++m)
#pragma unroll
                for (int n = 0; n < 2; ++n) acc[a][b][m][n] = (f32x4){0.f, 0.f, 0.f, 0.f};
    bf16x8 At[4][2], B0[2][2], B1[2][2];
    unsigned ca00, ca01, ca10, ca11, na00, na01, na10, na11;
    PG8_SETUP(cur, ca00, ca01, ca10, ca11);
    const char* cA = (const char*)cur.A; const char* cB = (const char*)cur.Bt; size_t chs = (size_t)HALF * cur.K * 2;
    const size_t kstep = (size_t)(BK * 2);
    { PG8_BOFF(cur.K, cb0, cb1);
    PG8_ST2(PG8_SB(0, 0), cB, cb0, cb1); PG8_ST2(PG8_SB(0, 1), cB + chs, cb0, cb1); PG8_ST2(PG8_SA(0, 0), cA, ca00, ca01); PG8_ST2(PG8_SA(0, 1), cA, ca10, ca11);
    if (wr == 1) PG8_BAR;
    PG8_WAIT_V(2); PG8_BAR;
    PG8_ST2(PG8_SB(1, 0), cB + kstep, cb0, cb1); PG8_ST2(PG8_SA(1, 0), cA + kstep, ca00, ca01); PG8_ST2(PG8_SB(1, 1), cB + chs + kstep, cb0, cb1);
    PG8_WAIT_V(6); PG8_BAR; }
    for (;;) {
        const bool has_next = S.next(ui + 1, nxt);
        if (!has_next) nxt = cur;
        PG8_SETUP(nxt, na00, na01, na10, na11);
        const char* nA = (const char*)nxt.A; const char* nB = (const char*)nxt.Bt; const size_t nhs = (size_t)HALF * nxt.K * 2;
        const int nt = cur.K >> 6;
        for (int t = 0; t < nt; t += 2) {
            const bool last = (t == nt - 2);
            const char* a1 = cA + (size_t)(t + 1) * kstep;
            const char* a2 = last ? nA : cA + (size_t)(t + 2) * kstep; const char* b2 = last ? nB : cB + (size_t)(t + 2) * kstep;
            const char* a3 = a2 + kstep; const char* b3 = b2 + kstep;
            const unsigned xa00 = last ? na00 : ca00, xa01 = last ? na01 : ca01, xa10 = last ? na10 : ca10, xa11 = last ? na11 : ca11;
            const int xK = last ? nxt.K : cur.K;
            const size_t xhs = last ? nhs : chs;
            PG8_LDB(B0, 0, 0); PG8_LDB(B1, 0, 1); PG8_SCHED; PG8_LDA(At, 0, 0); PG8_ST2(PG8_SA(1, 1), a1, ca10, ca11);
            PG8_WAIT_V(8); PG8_WAIT_L(0); PG8_BAR; PG8_MMA(0, 0, At, B0); PG8_MMA(0, 1, At, B1); PG8_BAR; PG8_SCHED;
            PG8_LDA(At, 0, 1); { PG8_BOFF(xK, xb0, xb1); PG8_ST2(PG8_SB(0, 0), b2, xb0, xb1); PG8_ST2(PG8_SB(0, 1), b2 + xhs, xb0, xb1); } PG8_ST2(PG8_SA(0, 0), a2, xa00, xa01);
            PG8_WAIT_V(8); PG8_WAIT_L(0); PG8_BAR; PG8_MMA(1, 0, At, B0); PG8_MMA(1, 1, At, B1); PG8_BAR; PG8_SCHED;
            PG8_LDB(B0, 1, 0); PG8_LDB(B1, 1, 1); PG8_SCHED; PG8_LDA(At, 1, 0); PG8_ST2(PG8_SA(0, 1), a2, xa10, xa11);
            PG8_WAIT_V(8); PG8_WAIT_L(0); PG8_BAR; PG8_MMA(0, 0, At, B0); PG8_MMA(0, 1, At, B1); PG8_BAR; PG8_SCHED;
            PG8_LDA(At, 1, 1); { PG8_BOFF(xK, xb0, xb1); PG8_ST2(PG8_SB(1, 0), b3, xb0, xb1); PG8_ST2(PG8_SB(1, 1), b3 + xhs, xb0, xb1); } PG8_ST2(PG8_SA(1, 0), a3, xa00, xa01);
            PG8_WAIT_V(8); PG8_WAIT_L(0); PG8_BAR; PG8_MMA(1, 0, At, B0); PG8_MMA(1, 1, At, B1); PG8_BAR; PG8_SCHED;
        }
        if (wr == 0) PG8_BAR;
        {
        const int el = otid() & 63, efr = el & 15, efq = el >> 4;
#pragma unroll
        for (int a = 0; a < 2; ++a)
#pragma unroll
            for (int b = 0; b < 2; ++b)
#pragma unroll
                for (int m = 0; m < 4; ++m) E(cur, 128 * a + 64 * wr + 16 * m + efr, 128 * b + 32 * wc + 4 * efq, acc[a][b][m][0], acc[a][b][m][1]);
        }
        if (!has_next) break;
#pragma unroll
        for (int a = 0; a < 2; ++a)
#pragma unroll
            for (int b = 0; b < 2; ++b)
#pragma unroll
                for (int m = 0; m < 4; ++m)
#pragma unroll
                    for (int n = 0; n < 2; ++n) acc[a][b][m][n] = (f32x4){0.f, 0.f, 0.f, 0.f};
        cur = nxt; cA = nA; cB = nB; chs = nhs; ca00 = na00; ca01 = na01; ca10 = na10; ca11 = na11; ++ui;
        if (wr == 1) PG8_BAR;
    }
    PG8_WAIT_V(0);
    PG8_BAR;
#undef PG8_SA
#undef PG8_SB
#undef PG8_ST2
#undef PG8_LDA
#undef PG8_LDB
#undef PG8_MMA
#undef PG8_WAIT_V
#undef PG8_WAIT_L
#undef PG8_BAR
#undef PG8_SCHED
#undef PG8_SETUP
#undef PG8_BOFF
}

__device__ __forceinline__ void st4bf(bf16_t* p, const f32x4& v) { u32x2 t; t[0] = pk2(v[0], v[1]); t[1] = pk2(v[2], v[3]); *(u32x2*)p = t; }

struct DenseSched {
    const bf16_t* A; const bf16_t* Bt; int nM, nN, K, G, c;
    __device__ __forceinline__ bool next(int i, GUnit& u) const {
        const int nwg = nM * nN; const long L = (long)i * G + c; if (L >= nwg) return false;
        int wgid = (int)L; { const int q = nwg / 8, r = nwg % 8, xcd = wgid % 8, off = wgid / 8; wgid = (xcd < r ? xcd * (q + 1) : r * (q + 1) + (xcd - r) * q) + off; }
        const int nig = 8 * nN, gid = wgid / nig, fm = gid * 8, gsz = (nM - fm) < 8 ? (nM - fm) : 8;
        const int pm = fm + ((wgid % nig) % gsz), pn = (wgid % nig) / gsz;
        u.A = A + (size_t)pm * 256 * K; u.gidx = nullptr; u.lst = nullptr; u.Bt = Bt + (size_t)pn * 256 * K; u.gvalid = 256; u.K = K; u.type = 0; u.pm = pm; u.pn = pn; u.aux = 0; return true;
    }
};
struct MoeSched {
    const int* ts; const int* cnt; const int* list; int down;
    const bf16_t* hA; const bf16_t* hidr; const bf16_t* hids; const bf16_t* wr_; const bf16_t* ws_; int G, c;
    __device__ __forceinline__ bool next(int i, GUnit& u) const {
        const int ntr = __builtin_amdgcn_readfirstlane(ts[64]), nr = down ? ntr * 4 : ntr * 2; const long L = (long)i * G + c; if (L >= nr + 256) return false;
        if (L < nr) {
            const int mt = down ? (int)(L >> 2) : (int)(L >> 1), pn = down ? (int)(L & 3) : (int)(L & 1); int e = 0;
            for (int q = 1; q < 64; ++q) if (ts[q] <= mt) e = q;
            e = __builtin_amdgcn_readfirstlane(e);
            const int base = (mt - __builtin_amdgcn_readfirstlane(ts[e])) * 256; const int valid = __builtin_amdgcn_readfirstlane(min(256, cnt[e] - base));
            u.type = 0; u.pm = mt; u.pn = pn; u.aux = e; u.gvalid = valid; u.lst = list + (size_t)e * NTOK + base;
            if (!down) { u.A = hA; u.gidx = u.lst; u.Bt = wr_ + ((size_t)e * 512 + pn * 256) * 1024; u.K = 1024; }
            else { u.A = hidr + (size_t)mt * 256 * 256; u.gidx = nullptr; u.Bt = wr_ + ((size_t)e * 1024 + pn * 256) * 256; u.K = 256; }
        } else {
            const int v = (int)(L - nr), pm = v >> 2, pn = v & 3;
            u.type = 1; u.pm = pm; u.pn = pn; u.aux = 0; u.gvalid = 256; u.gidx = nullptr; u.lst = nullptr;
            if (!down) { u.A = hA + (size_t)pm * 256 * 1024; u.Bt = ws_ + (size_t)pn * 256 * 1024; u.K = 1024; }
            else { u.A = hids + (size_t)pm * 256 * 512; u.Bt = ws_ + (size_t)pn * 256 * 512; u.K = 512; }
        }
        return true;
    }
};

struct EpiPlain { bf16_t* O; int planes;
    __device__ __forceinline__ void operator()(const GUnit& u, int r, int c, const f32x4& v0, const f32x4& v1) const {
        bf16_t* q = planes ? O + ((size_t)(u.pn >> 2) * NTOK + u.pm * 256 + r) * DM + (u.pn & 3) * 256 + c : O + (size_t)(u.pm * 256 + r) * DM + u.pn * 256 + c;
        st4bf(q, v0); st4bf(q + 16, v1); } };
struct EpiConvIn { bf16_t* Bb; bf16_t* Ub;
    __device__ __forceinline__ void operator()(const GUnit& u, int r, int c, const f32x4& v0, const f32x4& v1) const {
        const size_t row = (size_t)(u.pm * 256 + r);
        if (u.pn < 4) { bf16_t* q = Bb + row * DM + u.pn * 256 + c; st4bf(q, v0); st4bf(q + 16, v1); }
        else { const int uc = (u.pn - 4) * 128 + (c >> 5) * 16 + (c & 15); f32x4 t = v0 * v1; st4bf(Ub + row * DM + uc, t); } } };
struct EpiGU { bf16_t* Hr; bf16_t* Hs;
    __device__ __forceinline__ void operator()(const GUnit& u, int r, int c, const f32x4& v0, const f32x4& v1) const {
        f32x4 h; h[0] = siluf(v0[0]) * v1[0]; h[1] = siluf(v0[1]) * v1[1]; h[2] = siluf(v0[2]) * v1[2]; h[3] = siluf(v0[3]) * v1[3];
        const int col = u.pn * 128 + (c >> 5) * 16 + (c & 15); const size_t row = (size_t)(u.pm * 256 + r);
        st4bf(u.type == 0 ? Hr + row * 256 + col : Hs + row * 512 + col, h); } };
struct EpiDown { bf16_t* Y; const float* gates; const float* sg;
    __device__ __forceinline__ void operator()(const GUnit& u, int r, int c, const f32x4& v0, const f32x4& v1) const {
        if (u.type == 0) {
            if (r < u.gvalid) { const int e = u.lst[r]; const float g = gates[e];
                bf16_t* q = Y + ((size_t)(e & 1) * NTOK + (e >> 1)) * DM + u.pn * 256 + c; st4bf(q, v0 * g); st4bf(q + 16, v1 * g); }
        } else { const int row = u.pm * 256 + r; const float g = sg[row]; bf16_t* q = Y + ((size_t)2 * NTOK + row) * DM + u.pn * 256 + c; st4bf(q, v0 * g); st4bf(q + 16, v1 * g); } } };

__device__ __forceinline__ void phase_gemm_convin(const Params& p, unsigned char* lds) {
    DenseSched S; S.A = (const bf16_t*)(p.ws + WS_HA); S.Bt = (const bf16_t*)(p.ws + WS_W_CONVIN); S.nM = 64; S.nN = 12; S.K = 1024; S.G = ogrid(); S.c = oblk();
    EpiConvIn E; E.Bb = (bf16_t*)(p.ws + R_B); E.Ub = (bf16_t*)(p.ws + R_U);
    gemm_stream(lds, S, E);
}
__device__ __forceinline__ void phase_gemm_plain(const Params& p, unsigned char* lds, const bf16_t* A, const bf16_t* Bt, int nN, int K, bf16_t* O, int ldc, int planes) {
    DenseSched S; S.A = A; S.Bt = Bt; S.nM = 64; S.nN = nN; S.K = K; S.G = ogrid(); S.c = oblk();
    EpiPlain E; E.O = O; E.planes = planes;
    gemm_stream(lds, S, E);
}

__device__ __forceinline__ void moe_tiles(const Params& p, int l, int* ts) {
    if (otid() == 0) { const int* cnt = (const int*)(p.ws + WS_CTL) + l * 64; int s = 0; for (int e = 0; e < 64; ++e) { ts[e] = s; s += (cnt[e] + 255) >> 8; } ts[64] = s; }
    __syncthreads();
}
__device__ __forceinline__ void phase_moe_gu(const Params& p, unsigned char* lds, int l) {
    int* ts = (int*)(lds + 131072);
    moe_tiles(p, l, ts);
    MoeSched S; S.ts = ts; S.cnt = (const int*)(p.ws + WS_CTL) + l * 64; S.list = (const int*)(p.ws + WS_LIST); S.down = 0;
    S.hA = (const bf16_t*)(p.ws + WS_HA); S.hidr = nullptr; S.hids = nullptr; S.wr_ = (const bf16_t*)(p.ws + WS_W_MOEGU); S.ws_ = (const bf16_t*)(p.ws + WS_W_SHGU) + (size_t)l * 1024 * 1024; S.G = ogrid(); S.c = oblk();
    EpiGU E; E.Hr = (bf16_t*)(p.ws + R_HIDR); E.Hs = (bf16_t*)(p.ws + R_HIDS);
    gemm_stream(lds, S, E);
}
__device__ __forceinline__ void phase_moe_down(const Params& p, unsigned char* lds, int l) {
    int* ts = (int*)(lds + 131072);
    moe_tiles(p, l, ts);
    MoeSched S; S.ts = ts; S.cnt = (const int*)(p.ws + WS_CTL) + l * 64; S.list = (const int*)(p.ws + WS_LIST); S.down = 1;
    S.hA = nullptr; S.hidr = (const bf16_t*)(p.ws + R_HIDR); S.hids = (const bf16_t*)(p.ws + R_HIDS); S.wr_ = (const bf16_t*)(p.ws + WS_W_MOED); S.ws_ = (const bf16_t*)(p.ws + WS_W_SHD) + (size_t)l * 1024 * 512; S.G = ogrid(); S.c = oblk();
    EpiDown E; E.Y = (bf16_t*)(p.ws + R_YBUF); E.gates = (const float*)(p.ws + WS_GATES); E.sg = (const float*)(p.ws + WS_SG);
    gemm_stream(lds, S, E);
}

__device__ __forceinline__ void phase_gdn_prep(const Params& p, unsigned char* lds) {
    unsigned char* Qs = lds;
    unsigned char* Ks = lds + 17408;
    float* RHS = (float*)(lds + 34816);
    float* Lm = (float*)(lds + 34816 + 65536);
    float* betas = (float*)(lds + 34816 + 65536 + 16384);
    float* gcs = betas + 64;
    const bf16_t* planes = (const bf16_t*)(p.ws + R_PLANES);
    const float* ba = (const float*)(p.ws + WS_BA);
    bf16_t* Wn = (bf16_t*)(p.ws + R_WN); bf16_t* Qd = (bf16_t*)(p.ws + R_QD); bf16_t* KdT = (bf16_t*)(p.ws + R_KDT); bf16_t* UT = (bf16_t*)(p.ws + R_UT); bf16_t* At = (bf16_t*)(p.ws + R_AT);
    float* egl = (float*)(p.ws + WS_EGL);
    for (int cu = oblk(); cu < 2048; cu += ogrid()) {
        const int tid = otid(), lane = tid & 63, wid = tid >> 6;
        const int n = cu & 63, h = (cu >> 6) & 7, b = cu >> 9;
        const int tok0 = b * SEQ + n * 64;
        if (wid == 0) {
            const float bb = ba[(size_t)(tok0 + lane) * 16 + h], aa = ba[(size_t)(tok0 + lane) * 16 + 8 + h];
            const float beta = sigmf(bb);
            const float xs = aa + p.gdn_dt_bias[h];
            const float sp = fmaxf(xs, 0.f) + log1pf(__expf(-fabsf(xs)));
            float g = -__expf(p.gdn_a_log[h]) * sp;
#pragma unroll
            for (int o = 1; o < 64; o <<= 1) { const float t = __shfl_up(g, o); if (lane >= o) g += t; }
            betas[lane] = beta; gcs[lane] = g;
            if (lane == 63) egl[cu] = __expf(g);
        }
        __syncthreads();
        const float glast = gcs[63];
        {
            const int r = tid >> 3, cs = (tid & 7) * 16;
            const float beta = betas[r], gc = gcs[r];
#pragma unroll 1
            for (int pl = 0; pl < 3; ++pl) {
                float a[16];
#pragma unroll
                for (int i = 0; i < 16; ++i) a[i] = 0.f;
                const int ch = pl * 1024 + h * 128 + cs;
#pragma unroll
                for (int j = 0; j < 4; ++j) {
                    const int tt = n * 64 + r - 3 + j;
                    if (tt >= 0) {
                        const bf16_t* src = planes + ((size_t)pl * NTOK + (size_t)(b * SEQ + tt)) * DM + h * 128 + cs;
                        const u32x4 w0 = *(const u32x4*)src, w1 = *(const u32x4*)(src + 8);
                        const float* cw = p.gdn_conv_w + j * 3072 + ch;
                        const f32x4 c0 = *(const f32x4*)cw, c1 = *(const f32x4*)(cw + 4), c2 = *(const f32x4*)(cw + 8), c3 = *(const f32x4*)(cw + 12);
                        a[0] += c0[0] * bflo(w0[0]); a[1] += c0[1] * bfhi(w0[0]); a[2] += c0[2] * bflo(w0[1]); a[3] += c0[3] * bfhi(w0[1]);
                        a[4] += c1[0] * bflo(w0[2]); a[5] += c1[1] * bfhi(w0[2]); a[6] += c1[2] * bflo(w0[3]); a[7] += c1[3] * bfhi(w0[3]);
                        a[8] += c2[0] * bflo(w1[0]); a[9] += c2[1] * bfhi(w1[0]); a[10] += c2[2] * bflo(w1[1]); a[11] += c2[3] * bfhi(w1[1]);
                        a[12] += c3[0] * bflo(w1[2]); a[13] += c3[1] * bfhi(w1[2]); a[14] += c3[2] * bflo(w1[3]); a[15] += c3[3] * bfhi(w1[3]);
                    }
                }
                float ss = 0.f;
#pragma unroll
                for (int i = 0; i < 16; ++i) { a[i] = siluf(a[i]); ss += a[i] * a[i]; }
#pragma unroll
                for (int o = 1; o < 8; o <<= 1) ss += __shfl_xor(ss, o);
                if (pl == 0) {
                    const float rq = rsqrtf(ss + EPS) * 0.08838834764831845f, eg = __expf(gc);
                    unsigned qw[8], qdw[8];
#pragma unroll
                    for (int i = 0; i < 8; ++i) { const float q0 = a[2 * i] * rq, q1 = a[2 * i + 1] * rq; qw[i] = pk2(q0, q1); qdw[i] = pk2(q0 * eg, q1 * eg); }
                    *(u32x4*)(Qs + r * 272 + cs * 2) = (u32x4){qw[0], qw[1], qw[2], qw[3]}; *(u32x4*)(Qs + r * 272 + cs * 2 + 16) = (u32x4){qw[4], qw[5], qw[6], qw[7]};
                    bf16_t* qd = Qd + ((size_t)cu * 64 + r) * 128 + cs;
                    *(u32x4*)qd = (u32x4){qdw[0], qdw[1], qdw[2], qdw[3]}; *(u32x4*)(qd + 8) = (u32x4){qdw[4], qdw[5], qdw[6], qdw[7]};
                } else if (pl == 1) {
                    const float rk = rsqrtf(ss + EPS), ekd = __expf(glast - gc), kb = beta * __expf(gc);
                    unsigned kw[8];
#pragma unroll
                    for (int i = 0; i < 8; ++i) {
                        const float k0 = a[2 * i] * rk, k1 = a[2 * i + 1] * rk; kw[i] = pk2(k0, k1);
                        RHS[r * 256 + 128 + cs + 2 * i] = k0 * kb; RHS[r * 256 + 128 + cs + 2 * i + 1] = k1 * kb;
                        KdT[((size_t)cu * 128 + cs + 2 * i) * 64 + r] = (bf16_t)f2bf(k0 * ekd);
                        KdT[((size_t)cu * 128 + cs + 2 * i + 1) * 64 + r] = (bf16_t)f2bf(k1 * ekd);
                    }
                    *(u32x4*)(Ks + r * 272 + cs * 2) = (u32x4){kw[0], kw[1], kw[2], kw[3]}; *(u32x4*)(Ks + r * 272 + cs * 2 + 16) = (u32x4){kw[4], kw[5], kw[6], kw[7]};
                } else {
#pragma unroll
                    for (int i = 0; i < 16; ++i) RHS[r * 256 + cs + i] = a[i] * beta;
                }
            }
        }
        __syncthreads();
        {
            const int ti = wid & 3, isq = wid >> 2, fr = lane & 15, fq = lane >> 4;
            const unsigned char* Xs = isq ? Qs : Ks;
            bf16x8 af[4];
#pragma unroll
            for (int ks = 0; ks < 4; ++ks) af[ks] = *(const bf16x8*)(Xs + (16 * ti + fr) * 272 + (32 * ks + 8 * fq) * 2);
#pragma unroll
            for (int tj = 0; tj < 4; ++tj) {
                if (tj <= ti) {
                    f32x4 acc = (f32x4){0.f, 0.f, 0.f, 0.f};
#pragma unroll
                    for (int ks = 0; ks < 4; ++ks) { const bf16x8 bfg = *(const bf16x8*)(Ks + (16 * tj + fr) * 272 + (32 * ks + 8 * fq) * 2); acc = __builtin_amdgcn_mfma_f32_16x16x32_bf16(af[ks], bfg, acc, 0, 0, 0); }
                    const int jj = 16 * tj + fr; const float gj = gcs[jj];
#pragma unroll
                    for (int rg = 0; rg < 4; ++rg) {
                        const int ii = 16 * ti + 4 * fq + rg; const float gi = gcs[ii];
                        if (isq) { const float v = (ii >= jj) ? acc[rg] * __expf(gi - gj) : 0.f; At[((size_t)cu * 64 + ii) * 64 + jj] = (bf16_t)f2bf(v); }
                        else { Lm[jj * 64 + ii] = (ii > jj) ? acc[rg] * betas[ii] * __expf(gi - gj) : 0.f; }
                    }
                } else if (isq) {
#pragma unroll
                    for (int rg = 0; rg < 4; ++rg) At[((size_t)cu * 64 + 16 * ti + 4 * fq + rg) * 64 + 16 * tj + fr] = 0;
                }
            }
        }
        __syncthreads();
        if (tid < 256) {
            const int tid = otid();
            float rr[64];
#pragma unroll
            for (int i = 0; i < 64; ++i) rr[i] = RHS[i * 256 + tid];
            const bool isu = tid < 128;
            bf16_t* op = isu ? UT + ((size_t)cu * 128 + tid) * 64 : Wn + (size_t)cu * 64 * 128 + (tid - 128);
            const int ostr = isu ? 1 : 128;
            const unsigned sgn = isu ? 0u : 0x80000000u;
#pragma unroll
            for (int j = 0; j < 64; ++j) {
                const float xj = rr[j];
#pragma unroll
                for (int i4 = (j + 1) / 4; i4 < 16; ++i4) {
                    const f32x4 lv = *(const f32x4*)(Lm + j * 64 + 4 * i4);
#pragma unroll
                    for (int q = 0; q < 4; ++q) if (4 * i4 + q > j) rr[4 * i4 + q] -= lv[q] * xj;
                }
                op[j * ostr] = (bf16_t)f2bf(__uint_as_float(__float_as_uint(xj) ^ sgn));
                asm volatile("" ::: "memory");
            }
        }
        __syncthreads();
    }
}

__device__ __forceinline__ void phase_gdn_scan(const Params& p, unsigned char* lds) {
    const int tid = otid(), lane = tid & 63, wid = tid >> 6, fr = lane & 15, fq = lane >> 4;
    if (oblk() >= 64) {
        if (ogrid() > 64) {
            TJob* jobs = (TJob*)lds;
            if (tid == 0) moe_weight_jobs(p, 1, jobs);
            __syncthreads();
            run_tjobs(lds, 2, oblk() - 64, ogrid() - 64);
#ifdef PROBE_CONV2
            run_tjobs(lds, 2, oblk() - 64, ogrid() - 64);
#endif
        }
        return;
    }
    LAS unsigned char* L = (LAS unsigned char*)lds;
    constexpr int SLOT = 65536, ST_OFF = 131072, VT_OFF = 131072 + 17408;
    unsigned char* St = lds + ST_OFF;
    unsigned char* Vt = lds + VT_OFF;
    const float* egl = (const float*)(p.ws + WS_EGL);
    float* O = (float*)(p.ws + R_O);
    const int w = __builtin_amdgcn_readfirstlane(wid);
    const int cm = w >> 1, nq = w & 1;
    const int unit = oblk();
    const int nh = unit & 1, bh = unit >> 1, h = bh & 7, b = bh >> 3;
    const char* gsrc; size_t gstep; unsigned dst0; unsigned goff[8];
    {
        const bool wide = w < 4;
        const int pa0 = (w < 6) ? (w & 1) * 8 : 0;
        if (w < 2) { gsrc = (const char*)(p.ws + R_WN); gstep = 16384; dst0 = 0; }
        else if (w < 4) { gsrc = (const char*)(p.ws + R_QD); gstep = 16384; dst0 = 16384; }
        else if (w < 6) { gsrc = (const char*)(p.ws + R_KDT); gstep = 16384; dst0 = 32768; }
        else if (w == 6) { gsrc = (const char*)(p.ws + R_AT); gstep = 8192; dst0 = 49152; }
        else { gsrc = (const char*)(p.ws + R_UT) + (size_t)nh * 64 * 128; gstep = 16384; dst0 = 57344; }
        gsrc += (size_t)bh * 64 * gstep;
        dst0 += (unsigned)pa0 * 1024u;
#pragma unroll
        for (int i = 0; i < 8; ++i) {
            const int pa = pa0 + i;
            if (wide) { const int r = 4 * pa + (lane >> 4); goff[i] = (unsigned)(r * 256 + (((lane & 15) ^ (r & 15)) << 4)); }
            else { const int r = 8 * pa + (lane >> 3); goff[i] = (unsigned)(r * 128 + (((lane & 7) ^ ((r >> 1) & 7)) << 4)); }
        }
    }
#define SCAN_DMA(n_) do { const char* g_ = gsrc + (size_t)(n_) * gstep; const unsigned d_ = (unsigned)(((n_) & 1) * SLOT) + dst0; \
        _Pragma("unroll") for (int i = 0; i < 8; ++i) __builtin_amdgcn_global_load_lds((const unsigned*)(g_ + goff[i]), (LAS unsigned*)(L + d_ + i * 1024), 16, 0, 0); } while (0)
    const int rA = 16 * cm + fr;
    unsigned offW[4], offA[2], offK[2][2], offU[2];
#pragma unroll
    for (int ks = 0; ks < 4; ++ks) offW[ks] = (unsigned)(rA * 256 + (((4 * ks + fq) ^ (rA & 15)) << 4));
#pragma unroll
    for (int k2 = 0; k2 < 2; ++k2) {
        offA[k2] = (unsigned)(49152 + rA * 128 + (((4 * k2 + fq) ^ ((rA >> 1) & 7)) << 4));
#pragma unroll
        for (int d2 = 0; d2 < 2; ++d2) { const int r = 16 * (2 * cm + d2) + fr; offK[d2][k2] = (unsigned)(32768 + r * 128 + (((4 * k2 + fq) ^ ((r >> 1) & 7)) << 4)); }
    }
#pragma unroll
    for (int j = 0; j < 2; ++j) { const int r = 16 * (2 * nq + j) + fr; offU[j] = (unsigned)(57344 + r * 128 + (((2 * cm + (fq >> 1)) ^ ((r >> 1) & 7)) << 4) + 8 * (fq & 1)); }
    for (int i = tid; i < 17408 / 4; i += NT) ((unsigned*)St)[i] = 0u;
    f32x4 sacc[2][2];
#pragma unroll
    for (int a = 0; a < 2; ++a)
#pragma unroll
        for (int c = 0; c < 2; ++c) sacc[a][c] = (f32x4){0.f, 0.f, 0.f, 0.f};
    SCAN_DMA(0);
    float egn = egl[(size_t)bh * 64];
    asm volatile("s_waitcnt vmcnt(0)" ::: "memory");
    __syncthreads();
#pragma unroll 1
    for (int n = 0; n < 64; ++n) {
        const float eg = egn;
        if (n + 1 < 64) { SCAN_DMA(n + 1); egn = egl[(size_t)bh * 64 + n + 1]; }
        const unsigned sb = (unsigned)((n & 1) * SLOT);
        bf16x8 sf[2][4];
#pragma unroll
        for (int j = 0; j < 2; ++j)
#pragma unroll
            for (int ks = 0; ks < 4; ++ks) sf[j][ks] = *(const bf16x8*)(St + (16 * (2 * nq + j) + fr) * 272 + (32 * ks + 8 * fq) * 2);
        {
            bf16x8 wf[4];
#pragma unroll
            for (int ks = 0; ks < 4; ++ks) wf[ks] = *(const LAS bf16x8*)(L + sb + offW[ks]);
#pragma unroll
            for (int j = 0; j < 2; ++j) {
                const u32x2 uu = *(const LAS u32x2*)(L + sb + offU[j]);
                f32x4 a1 = (f32x4){bflo(uu[0]), bfhi(uu[0]), bflo(uu[1]), bfhi(uu[1])};
#pragma unroll
                for (int ks = 0; ks < 4; ++ks) a1 = __builtin_amdgcn_mfma_f32_16x16x32_bf16(wf[ks], sf[j][ks], a1, 0, 0, 0);
                u32x2 t; t[0] = pk2(a1[0], a1[1]); t[1] = pk2(a1[2], a1[3]);
                *(u32x2*)(Vt + (16 * (2 * nq + j) + fr) * 144 + (16 * cm + 4 * fq) * 2) = t;
            }
        }
        asm volatile("s_waitcnt lgkmcnt(0)" ::: "memory"); __builtin_amdgcn_s_barrier(); asm volatile("" ::: "memory");
        bf16x8 vf[2][2];
#pragma unroll
        for (int j = 0; j < 2; ++j)
#pragma unroll
            for (int k2 = 0; k2 < 2; ++k2) vf[j][k2] = *(const bf16x8*)(Vt + (16 * (2 * nq + j) + fr) * 144 + (32 * k2 + 8 * fq) * 2);
        {
            bf16x8 qf[4], af[2];
#pragma unroll
            for (int ks = 0; ks < 4; ++ks) qf[ks] = *(const LAS bf16x8*)(L + sb + 16384 + offW[ks]);
#pragma unroll
            for (int k2 = 0; k2 < 2; ++k2) af[k2] = *(const LAS bf16x8*)(L + sb + offA[k2]);
#pragma unroll
            for (int j = 0; j < 2; ++j) {
                f32x4 a2 = (f32x4){0.f, 0.f, 0.f, 0.f};
#pragma unroll
                for (int ks = 0; ks < 4; ++ks) a2 = __builtin_amdgcn_mfma_f32_16x16x32_bf16(sf[j][ks], qf[ks], a2, 0, 0, 0);
#pragma unroll
                for (int k2 = 0; k2 < 2; ++k2) a2 = __builtin_amdgcn_mfma_f32_16x16x32_bf16(vf[j][k2], af[k2], a2, 0, 0, 0);
                *(f32x4*)(O + (size_t)(b * SEQ + n * 64 + 16 * cm + fr) * DM + h * 128 + nh * 64 + 16 * (2 * nq + j) + 4 * fq) = a2;
            }
        }
#pragma unroll
        for (int d2 = 0; d2 < 2; ++d2) {
            bf16x8 kf[2];
#pragma unroll
            for (int k2 = 0; k2 < 2; ++k2) kf[k2] = *(const LAS bf16x8*)(L + sb + offK[d2][k2]);
#pragma unroll
            for (int j = 0; j < 2; ++j) {
                sacc[d2][j] = sacc[d2][j] * eg;
#pragma unroll
                for (int k2 = 0; k2 < 2; ++k2) sacc[d2][j] = __builtin_amdgcn_mfma_f32_16x16x32_bf16(kf[k2], vf[j][k2], sacc[d2][j], 0, 0, 0);
                u32x2 t; t[0] = pk2(sacc[d2][j][0], sacc[d2][j][1]); t[1] = pk2(sacc[d2][j][2], sacc[d2][j][3]);
                *(u32x2*)(St + (16 * (2 * nq + j) + fr) * 272 + (16 * (2 * cm + d2) + 4 * fq) * 2) = t;
            }
        }
        asm volatile("s_waitcnt vmcnt(0) lgkmcnt(0)" ::: "memory"); __builtin_amdgcn_s_barrier(); asm volatile("" ::: "memory");
    }
#undef SCAN_DMA
}

#define XB_TMO      128
#define XB_XCNT(j)  (256  + 64 * (j))
#define XB_XSUB(j)  (1280 + 64 * (j))
#define XB_XGEN(j)  (2304 + 64 * (j))
#define XB_TOP      3328
#define XB_TOPGEN   3392
#define XCD_BAR_WORDS 3456
#define XB_SPIN_CAP (1u << 18)
constexpr int CW_BAR = 4096;
__device__ __forceinline__ unsigned xb_ld(unsigned* p)              { return __hip_atomic_load(p, __ATOMIC_RELAXED, __HIP_MEMORY_SCOPE_AGENT); }
__device__ __forceinline__ unsigned xb_add(unsigned* p, unsigned v) { return __hip_atomic_fetch_add(p, v, __ATOMIC_RELAXED, __HIP_MEMORY_SCOPE_AGENT); }
__device__ __forceinline__ unsigned xb_xcc_id() { return (unsigned)__builtin_amdgcn_s_getreg((3 << 11) | 20) & 0xFu; }
#define XB_SPIN(cond, bar) do { unsigned _sp = 0; while (cond) { __builtin_amdgcn_s_sleep(1); \
    if ((++_sp & 255u) == 0u) { if (xb_ld(&(bar)[XB_TMO])) break; if (_sp > XB_SPIN_CAP) { atomicAdd(&(bar)[XB_TMO], 1u); break; } } } } while (0)
struct XcdBarrier { unsigned* bar; unsigned x; volatile LAS unsigned* st; };
__device__ __forceinline__ XcdBarrier xcd_barrier_post(unsigned* bar, volatile LAS unsigned* st) {
    XcdBarrier b; b.bar = bar; b.x = xb_xcc_id(); b.st = st;
    if (threadIdx.x == 0) (void)xb_add(&bar[XB_XCNT(b.x)], 1u);
    return b;
}
__device__ __forceinline__ void xcd_barrier_complete(unsigned* bar, unsigned x, unsigned& nloc, unsigned& nx) {
    const unsigned G = gridDim.x * gridDim.y * gridDim.z;
    unsigned sum, cnt, mine, sp = 0u;
    for (;;) {
        sum = 0u; cnt = 0u; mine = 0u;
#pragma unroll
        for (unsigned j = 0; j < 16; ++j) { const unsigned c = xb_ld(&bar[XB_XCNT(j)]); sum += c; cnt += (c > 0u) ? 1u : 0u; mine = (j == x) ? c : mine; }
        if (sum == G) break;
        __builtin_amdgcn_s_sleep(1);
        if ((++sp & 255u) == 0u) { if (xb_ld(&bar[XB_TMO])) break; if (sp > XB_SPIN_CAP) { atomicAdd(&bar[XB_TMO], 1u); break; } }
    }
    nloc = mine > 0u ? mine : 1u; nx = cnt > 0u ? cnt : 1u;
}
__device__ __forceinline__ void xcd_barrier(const XcdBarrier& b) {
    asm volatile("s_waitcnt vmcnt(0)" ::: "memory");
    __syncthreads();
    if (threadIdx.x == 0) {
        unsigned* bar = b.bar;
        __builtin_amdgcn_s_waitcnt(0);
        unsigned nloc = b.st[0], nx = b.st[1];
        if (nloc == 0u) { xcd_barrier_complete(bar, b.x, nloc, nx); b.st[0] = nloc; b.st[1] = nx; }
        const unsigned old = xb_add(&bar[XB_XSUB(b.x)], 1u);
        const unsigned gen = old / nloc;
        if (old + 1u == (gen + 1u) * nloc) {
            __builtin_amdgcn_fence(__ATOMIC_RELEASE, "agent");
            asm volatile("s_waitcnt vmcnt(0)" ::: "memory");
            const unsigned og = xb_add(&bar[XB_TOP], 1u);
            const unsigned tg = og / nx;
            if (og + 1u == (tg + 1u) * nx) xb_add(&bar[XB_TOPGEN], 1u);
            else XB_SPIN(xb_ld(&bar[XB_TOPGEN]) == tg, bar);
            __builtin_amdgcn_fence(__ATOMIC_ACQUIRE, "agent");
            xb_add(&bar[XB_XGEN(b.x)], 1u);
            asm volatile("s_waitcnt vmcnt(0)" ::: "memory");
        } else {
            XB_SPIN(xb_ld(&bar[XB_XGEN(b.x)]) == gen, bar);
            __builtin_amdgcn_fence(__ATOMIC_ACQUIRE, "agent");
            asm volatile("s_waitcnt vmcnt(0)" ::: "memory");
        }
    }
    __syncthreads();
}

typedef const __attribute__((address_space(4))) Params* KArgP;
__device__ __forceinline__ KArgP kargs() { KArgP v = (KArgP)__builtin_amdgcn_kernarg_segment_ptr(); asm volatile("" : "+s"(v)); return v; }
#define LF(f) q.f = pp->f;
#define WS_BF(off) ((bf16_t*)(q.ws + (off)))
#ifndef REPMASK
#define REPMASK 0
#endif
#define PH(n, FIELDS, ...) if (p.ph_lo <= (n) && (n) < p.ph_hi) { { KArgP pp = kargs(); Params q; FIELDS LF(ws) __VA_ARGS__; } \
    if ((REPMASK >> (n)) & 1) { xcd_barrier(bar); { KArgP pp = kargs(); Params q; FIELDS LF(ws) __VA_ARGS__; } } if ((n) + 1 < p.ph_hi) xcd_barrier(bar); }
__global__ void __launch_bounds__(NT) mega_fwd(Params p) {
    __shared__ __attribute__((aligned(16))) unsigned char lds[LDS_BYTES];
    volatile LAS unsigned* bst = (volatile LAS unsigned*)(LAS unsigned char*)(lds + LDS_BYTES - 16);
    if (threadIdx.x < 4) bst[threadIdx.x] = 0u;
    __syncthreads();
    const XcdBarrier bar = xcd_barrier_post((unsigned*)(p.ws + WS_CTL) + CW_BAR, bst);
    PH(0, LF(c) LF(ada_w) LF(ada_b) LF(conv_in_w) LF(conv_out_w) LF(gdn_in_w) LF(gdn_out_w) LF(sh_w_gate) LF(sh_w_up) LF(sh_w_down) LF(moe_w_gate) LF(moe_w_up) LF(moe_w_down), phase_prologue(q, lds))
    PH(1, LF(x) LF(norm_w), phase_h0(q))
    PH(2, , phase_gemm_convin(q, lds))
    PH(3, LF(conv_w), phase_conv(q))
    PH(4, , phase_gemm_plain(q, lds, WS_BF(WS_HA), WS_BF(WS_W_CONVOUT), 4, 1024, WS_BF(R_YO), 1024, 0))
    PH(5, LF(x) LF(out) LF(norm_w) LF(moe_expert_w) LF(moe_group_w) LF(sh_gate_w) LF(moe_group_b) LF(moe_expert_b), phase_post_mixer(q, lds, 0))
    PH(6, , phase_moe_gu(q, lds, 0))
    PH(7, , phase_moe_down(q, lds, 0))
    PH(8, LF(out) LF(norm_w) LF(gdn_in_w), phase_post_moe(q, lds, 0, false))
    PH(9, , phase_gemm_plain(q, lds, WS_BF(WS_HA), WS_BF(WS_W_GDNIN), 16, 1024, WS_BF(R_PLANES), 1024, 1))
    PH(10, LF(gdn_conv_w) LF(gdn_dt_bias) LF(gdn_a_log), phase_gdn_prep(q, lds))
    PH(11, LF(moe_w_gate) LF(moe_w_up) LF(moe_w_down), phase_gdn_scan(q, lds))
    PH(12, LF(gdn_norm_w), phase_gdn_gate(q))
    PH(13, , phase_gemm_plain(q, lds, WS_BF(WS_HA), WS_BF(WS_W_GDNOUT), 4, 1024, WS_BF(R_YO), 1024, 0))
    PH(14, LF(x) LF(out) LF(norm_w) LF(moe_expert_w) LF(moe_group_w) LF(sh_gate_w) LF(moe_group_b) LF(moe_expert_b), phase_post_mixer(q, lds, 1))
    PH(15, , phase_moe_gu(q, lds, 1))
    PH(16, , phase_moe_down(q, lds, 1))
    PH(17, LF(out) LF(norm_w) LF(gdn_in_w), phase_post_moe(q, lds, 1, true))
}

extern "C" void kernel_launch(void* const* d_in, const int* in_sizes, int n_in, void* d_out, int out_size, void* d_ws, size_t ws_size, hipStream_t stream) {
    static int grid_blocks = 0;
    if (!grid_blocks) {
        int dev = 0, cus = 0, per_cu = 0;
        hipGetDevice(&dev);
        hipDeviceGetAttribute(&cus, hipDeviceAttributeMultiprocessorCount, dev);
        hipOccupancyMaxActiveBlocksPerMultiprocessor(&per_cu, mega_fwd, NT, 0);
        if (per_cu < 1) { fprintf(stderr, "kernel_launch: occupancy query says %d blocks per CU\n", per_cu); per_cu = 1; }
        grid_blocks = cus;
        if (ws_size < WS_END) fprintf(stderr, "kernel_launch: workspace too small: %zu < %zu\n", ws_size, (size_t)WS_END);
    }
    Params p{};
    const float** f = (const float**)&p;
    for (int i = 0; i < 25; ++i) f[i] = (const float*)d_in[i];
    p.out = (float*)d_out; p.ws = (unsigned char*)d_ws;
    hipMemsetAsync((char*)d_ws + WS_CTL, 0, 65536, stream);
#if N_LAUNCH_MODE
    for (int ph = 0; ph < NPHASE; ++ph) {
        p.ph_lo = ph; p.ph_hi = ph + 1;
        hipLaunchKernelGGL(mega_fwd, dim3(grid_blocks), dim3(NT), 0, stream, p);
    }
#else
    p.ph_lo = 0; p.ph_hi = NPHASE;
    void* args[] = {&p};
    hipError_t e = hipLaunchCooperativeKernel((void*)mega_fwd, dim3(grid_blocks), dim3(NT), args, 0, stream);
    if (e != hipSuccess) fprintf(stderr, "cooperative launch failed: %s (grid %d)\n", hipGetErrorString(e), grid_blocks);
#endif
}
```
